# Optimizing an MI355X kernel written in HIP

```python
import math
import jax
import jax.numpy as jnp
from jax import lax

D_MODEL = 1024
BATCH = 8
SEQ = 4096
DEPTH = 2

CTX_LEN = 256
GRID_W = 64
D_SSD = 2 * D_MODEL
SSD_HEAD_DIM = 64
SSD_HEADS = D_SSD // SSD_HEAD_DIM
SSD_GROUPS = 4
SSD_STATE = 128
SSD_CHUNK = 128
CONV_WIDTH = 5
D_XBC = D_SSD + 2 * SSD_GROUPS * SSD_STATE
D_GM = D_MODEL
GM_CHUNK = 128
GM_GROUPS = 8
GM_GROUP_CH = D_GM // GM_GROUPS
N_BRANCH = 2
OFF_XBC = D_SSD
OFF_DT = OFF_XBC + D_XBC
OFF_U = OFF_DT + 2 * SSD_HEADS
OFF_V = OFF_U + D_GM
OFF_GATE = OFF_V + D_GM
D_IN = OFF_GATE + N_BRANCH * D_MODEL
D_FF = 2816
N_EXPERTS = 8
TOP_K = 2
D_FF_EXPERT = 3584
N_DENSE = (DEPTH + 1) // 2
N_MOE = DEPTH // 2
N_MOD = 6
EPS = 1e-6

kernel_name = 'hybrid_ssd_gmlp_moe_dit_block'


def rmsnorm(x, g):
    xf = x.astype(jnp.float32)
    y = xf * lax.rsqrt(jnp.mean(xf * xf, axis=-1, keepdims=True) + EPS)
    return (y * g.astype(jnp.float32)).astype(x.dtype)


def modulate(h, shift, scale):
    return h * (1 + scale) + shift


def dwconv_centred(u, w, b):
    k_w = w.shape[0]
    n = u.shape[-2]
    half = k_w // 2
    up = jnp.pad(u, [(0, 0)] * (u.ndim - 2) + [(half, half), (0, 0)])
    out = b
    for k in range(k_w):
        out = out + w[k] * up[..., k:k + n, :]
    return out


def ssd_chunked(xdt, a, b_in, c_in, h0, with_output):
    bsz, L, H, P = xdt.shape
    G, N = b_in.shape[-2:]
    nc = L // SSD_CHUNK
    Q = SSD_CHUNK
    hg = H // G
    xc = xdt.reshape(bsz, nc, Q, G, hg, P)
    bc = b_in.reshape(bsz, nc, Q, G, N)
    cc = c_in.reshape(bsz, nc, Q, G, N)
    acs = jnp.cumsum(a.astype(jnp.float32).reshape(bsz, nc, Q, G, hg), axis=2)
    a_tot = acs[:, :, -1]
    decay_to_end = jnp.exp(a_tot[:, :, None] - acs)
    chunk_states = jnp.einsum('bclgn,bclgh,bclghp->bcghpn', bc, decay_to_end, xc).astype(jnp.float32)

    def step(h, inp):
        s_c, at = inp
        return jnp.exp(at)[..., None, None] * h + s_c, h

    h_final, h_in = lax.scan(step, h0, (jnp.moveaxis(chunk_states, 1, 0), jnp.moveaxis(a_tot, 1, 0)))
    if not with_output:
        return None, h_final
    h_in = jnp.moveaxis(h_in, 0, 1)
    seg = acs[:, :, :, None] - acs[:, :, None, :]
    lower_tri = jnp.tril(jnp.ones((Q, Q), dtype=bool))[:, :, None, None]
    decay = jnp.exp(jnp.where(lower_tri, seg, -jnp.inf))
    cb = jnp.einsum('bclgn,bcsgn->bclsg', cc, bc)
    y_diag = jnp.einsum('bclsg,bclsgh,bcsghp->bclghp', cb, decay, xc)
    y_off = jnp.einsum('bclgn,bcghpn,bclgh->bclghp', cc, h_in, jnp.exp(acs))
    return (y_diag + y_off).reshape(bsz, L, H, P), h_final


def hybrid_mixer(h, lp, h0_f, h0_b, on_grid, with_output):
    bsz, L, _ = h.shape
    if with_output:
        z, xbc, dt, u, v, gl = jnp.split(h @ lp['w_in'], [OFF_XBC, OFF_DT, OFF_U, OFF_V, OFF_GATE], axis=-1)
    else:
        xbc, dt = jnp.split(h @ lp['w_in'][:, OFF_XBC:OFF_U], [D_XBC], axis=-1)
    if on_grid:
        rows = L // GRID_W
        xbc = dwconv_centred(xbc.reshape(bsz, rows, GRID_W, D_XBC), lp['conv_w'], lp['conv_b']).reshape(bsz, L, D_XBC)
    else:
        xbc = dwconv_centred(xbc, lp['conv_w'], lp['conv_b'])
    xbc = jax.nn.silu(xbc)
    xs, bm, cm = jnp.split(xbc, [D_SSD, D_SSD + SSD_GROUPS * SSD_STATE], axis=-1)
    xs = xs.reshape(bsz, L, SSD_HEADS, SSD_HEAD_DIM)
    bm = bm.reshape(bsz, L, SSD_GROUPS, SSD_STATE)
    cm = cm.reshape(bsz, L, SSD_GROUPS, SSD_STATE)
    dt = jax.nn.softplus(dt.astype(jnp.float32).reshape(bsz, L, 2, SSD_HEADS) + lp['dt_bias'].astype(jnp.float32))
    a_neg = -jnp.exp(lp['a_log'].astype(jnp.float32))
    flip = lambda t: jnp.flip(t, axis=1)
    y_f, hf_f = ssd_chunked(xs * dt[:, :, 0, :, None], dt[:, :, 0] * a_neg[0], bm, cm, h0_f, with_output)
    y_b, hf_b = ssd_chunked(flip(xs * dt[:, :, 1, :, None]), flip(dt[:, :, 1] * a_neg[1]), flip(bm), flip(cm), h0_b, with_output)
    if not with_output:
        return None, hf_f, hf_b
    y = (y_f + flip(y_b) + xs * lp['d_skip'][:, None]).reshape(bsz, L, D_SSD).astype(h.dtype)
    y_ssd = rmsnorm(y * jax.nn.silu(z), lp['ssd_norm_g'])
    u = jax.nn.gelu(u)
    v = rmsnorm(jax.nn.gelu(v), lp['gm_norm_g'])
    v = v.reshape(bsz, L // GM_CHUNK, GM_CHUNK, GM_GROUPS, GM_GROUP_CH)
    s = jnp.einsum('gts,bnsgc->bntgc', lp['w_spatial'], v) + lp['b_spatial'].T[None, None, :, :, None]
    y_gm = u * s.reshape(bsz, L, D_GM)
    gates = jax.nn.sigmoid(gl.astype(jnp.float32)).astype(h.dtype).reshape(bsz, L, N_BRANCH, D_MODEL)
    merged = gates[:, :, 0] * (y_ssd @ lp['w_ssd_br']) + gates[:, :, 1] * (y_gm @ lp['w_gm_br'])
    return merged @ lp['w_out'], hf_f, hf_b


def swiglu(h, w_gate, w_up, w_down):
    return (jax.nn.silu(h @ w_gate) * (h @ w_up)) @ w_down


def moe_swiglu(h, w_router, b_router, w_gate, w_up, w_down):
    shp = h.shape
    t = h.reshape(-1, shp[-1])
    logits = (t @ w_router).astype(jnp.float32) + b_router.astype(jnp.float32)
    top_val, top_idx = lax.top_k(logits, TOP_K)
    top_p = jax.nn.softmax(top_val, axis=-1)
    combine = jnp.einsum('tk,tke->te', top_p, jax.nn.one_hot(top_idx, N_EXPERTS, dtype=jnp.float32)).astype(h.dtype)
    out = jnp.zeros_like(t)
    for e in range(N_EXPERTS):
        out = out + combine[:, e:e + 1] * swiglu(t, w_gate[e], w_up[e], w_down[e])
    return out.reshape(shp)


def channel_mixer(h, i, ffn_w_gate, ffn_w_up, ffn_w_down, moe_router_w, moe_router_b, moe_w_gate, moe_w_up, moe_w_down):
    j = i // 2
    if i % 2 == 0:
        return swiglu(h, ffn_w_gate[j], ffn_w_up[j], ffn_w_down[j])
    return moe_swiglu(h, moe_router_w[j], moe_router_b[j], moe_w_gate[j], moe_w_up[j], moe_w_down[j])


def setup_inputs(seed: int = 0) -> dict:
    key = jax.random.key(seed)
    ks = jax.random.split(key, 32)
    f32 = jnp.float32

    def nrm(k, shape, fan_in):
        return jax.random.normal(k, shape, f32) * (fan_in ** -0.5)

    def gain(k, shape):
        return 1.0 + 0.02 * jax.random.normal(k, shape, f32)

    dt0 = jnp.exp(jax.random.uniform(ks[9], (DEPTH, 2, SSD_HEADS), f32, math.log(1e-3), math.log(1e-1)))
    return {
        'x': jax.random.normal(ks[0], (BATCH, SEQ, D_MODEL), f32),
        'c': jax.random.normal(ks[1], (BATCH, D_MODEL), f32),
        'ctx': jax.random.normal(ks[2], (BATCH, CTX_LEN, D_MODEL), f32),
        'c_ctx': jax.random.normal(ks[3], (D_MODEL,), f32),
        'w_ada': nrm(ks[4], (DEPTH, D_MODEL, N_MOD * D_MODEL), D_MODEL),
        'b_ada': 0.02 * jax.random.normal(ks[5], (DEPTH, N_MOD * D_MODEL), f32),
        'norm1_g': gain(ks[6], (DEPTH, D_MODEL)),
        'w_in': nrm(ks[7], (DEPTH, D_MODEL, D_IN), D_MODEL),
        'conv_w': nrm(ks[8], (DEPTH, CONV_WIDTH, D_XBC), CONV_WIDTH),
        'conv_b': 0.02 * jax.random.normal(ks[10], (DEPTH, D_XBC), f32),
        'dt_bias': dt0 + jnp.log(-jnp.expm1(-dt0)),
        'a_log': jnp.log(jax.random.uniform(ks[11], (DEPTH, 2, SSD_HEADS), f32, 1.0, 16.0)),
        'd_skip': gain(ks[12], (DEPTH, SSD_HEADS)),
        'ssd_norm_g': gain(ks[13], (DEPTH, D_SSD)),
        'w_ssd_br': nrm(ks[14], (DEPTH, D_SSD, D_MODEL), D_SSD),
        'gm_norm_g': gain(ks[15], (DEPTH, D_GM)),
        'w_spatial': nrm(ks[16], (DEPTH, GM_GROUPS, GM_CHUNK, GM_CHUNK), GM_CHUNK),
        'b_spatial': gain(ks[17], (DEPTH, GM_GROUPS, GM_CHUNK)),
        'w_gm_br': nrm(ks[18], (DEPTH, D_GM, D_MODEL), D_GM),
        'w_out': nrm(ks[19], (DEPTH, D_MODEL, D_MODEL), D_MODEL),
        'norm2_g': gain(ks[20], (DEPTH, D_MODEL)),
        'ffn_w_gate': nrm(ks[21], (N_DENSE, D_MODEL, D_FF), D_MODEL),
        'ffn_w_up': nrm(ks[22], (N_DENSE, D_MODEL, D_FF), D_MODEL),
        'ffn_w_down': nrm(ks[23], (N_DENSE, D_FF, D_MODEL), D_FF),
        'moe_router_w': nrm(ks[24], (N_MOE, D_MODEL, N_EXPERTS), D_MODEL),
        'moe_router_b': 0.01 * jax.random.normal(ks[25], (N_MOE, N_EXPERTS), f32),
        'moe_w_gate': nrm(ks[26], (N_MOE, N_EXPERTS, D_MODEL, D_FF_EXPERT), D_MODEL),
        'moe_w_up': nrm(ks[27], (N_MOE, N_EXPERTS, D_MODEL, D_FF_EXPERT), D_MODEL),
        'moe_w_down': nrm(ks[28], (N_MOE, N_EXPERTS, D_FF_EXPERT, D_MODEL), D_FF_EXPERT),
        'final_norm_g': gain(ks[29], (D_MODEL,)),
    }


def reference(x, c, ctx, c_ctx, w_ada, b_ada, norm1_g, w_in, conv_w, conv_b, dt_bias, a_log,
              d_skip, ssd_norm_g, w_ssd_br, gm_norm_g, w_spatial, b_spatial, w_gm_br, w_out,
              norm2_g, ffn_w_gate, ffn_w_up, ffn_w_down, moe_router_w, moe_router_b,
              moe_w_gate, moe_w_up, moe_w_down, final_norm_g):
    bsz = x.shape[0]
    h_zero = jnp.zeros((bsz, SSD_GROUPS, SSD_HEADS // SSD_GROUPS, SSD_HEAD_DIM, SSD_STATE), jnp.float32)
    for i in range(DEPTH):
        last = i == DEPTH - 1
        lp = dict(w_in=w_in[i], conv_w=conv_w[i], conv_b=conv_b[i], dt_bias=dt_bias[i], a_log=a_log[i],
                  d_skip=d_skip[i], ssd_norm_g=ssd_norm_g[i], w_ssd_br=w_ssd_br[i], gm_norm_g=gm_norm_g[i],
                  w_spatial=w_spatial[i], b_spatial=b_spatial[i], w_gm_br=w_gm_br[i], w_out=w_out[i])
        mod_x = (jax.nn.silu(c) @ w_ada[i] + b_ada[i]).reshape(bsz, N_MOD, 1, D_MODEL)
        mod_c = (jax.nn.silu(c_ctx) @ w_ada[i] + b_ada[i]).reshape(N_MOD, 1, D_MODEL)
        hc = modulate(rmsnorm(ctx, norm1_g[i]), mod_c[0], mod_c[1])
        ctx_mix, st_f, st_b = hybrid_mixer(hc, lp, h_zero, h_zero, False, not last)
        hx = modulate(rmsnorm(x, norm1_g[i]), mod_x[:, 0], mod_x[:, 1])
        x_mix, _, _ = hybrid_mixer(hx, lp, st_f, st_b, True, True)
        x = x + mod_x[:, 2] * x_mix
        hx = modulate(rmsnorm(x, norm2_g[i]), mod_x[:, 3], mod_x[:, 4])
        x = x + mod_x[:, 5] * channel_mixer(hx, i, ffn_w_gate, ffn_w_up, ffn_w_down, moe_router_w,
                                            moe_router_b, moe_w_gate, moe_w_up, moe_w_down)
        if not last:
            ctx = ctx + mod_c[2] * ctx_mix
            hc = modulate(rmsnorm(ctx, norm2_g[i]), mod_c[3], mod_c[4])
            ctx = ctx + mod_c[5] * channel_mixer(hc, i, ffn_w_gate, ffn_w_up, ffn_w_down, moe_router_w,
                                                moe_router_b, moe_w_gate, moe_w_up, moe_w_down)
    return rmsnorm(x, final_norm_g)
```

```cpp
#include <hip/hip_runtime.h>
#include <cstdio>
#include <cstdint>
#include <cstring>

#ifndef MK_PER_PHASE
#define MK_PER_PHASE 0
#endif

#ifndef I8_UP
#define I8_UP 1
#endif
#ifndef FP8_FFN
#define FP8_FFN 1
#endif
#define LAS __attribute__((address_space(3)))
typedef unsigned short bf16_t;
typedef short bf16x8 __attribute__((ext_vector_type(8)));
typedef float f32x4 __attribute__((ext_vector_type(4)));
typedef float f32x2 __attribute__((ext_vector_type(2)));
typedef float f32x16 __attribute__((ext_vector_type(16)));
typedef unsigned u32x4 __attribute__((ext_vector_type(4)));
typedef unsigned u32x2 __attribute__((ext_vector_type(2)));

constexpr int DM = 1024, NB = 8, SEQ = 4096, CTXL = 256;
constexpr int TPB = CTXL + SEQ;
constexpr int T = NB * TPB;
constexpr int NTILE = T / 256;
constexpr int NLT = NB * 16;
constexpr int DSSD = 2048, NH = 32, HDIM = 64, NGRP = 4, NST = 128, CHK = 128;
constexpr int NCB = TPB / CHK;
constexpr int NCHUNK = NB * NCB;
constexpr int DXBC = 3072, DIN = 9280, OFF_XBC = 2048, OFF_DT = 5120, OFF_U = 5184, OFF_V = 6208, OFF_GATE = 7232;
constexpr int DFF = 2816, NE = 8, DFFE = 3584;
constexpr int NG1 = 3328, NG2 = 6144;
constexpr float EPS = 1e-6f;
constexpr int MOE_MAXT = 264;
constexpr int MOE_SPLIT = 128, MOE_HALF = 136;

constexpr size_t MiB = 1u << 20;
constexpr size_t WS_CTL = 0, CTL_BYTES = 1 * MiB;
constexpr size_t WS_MOD = 1 * MiB;
constexpr size_t WS_SA = 1 * MiB + 512 * 1024, WS_SA2 = 1 * MiB + 704 * 1024;
constexpr size_t WS_CTXRES = 2 * MiB;
constexpr size_t WS_WL = 10 * MiB, WL_STRIDE = 19 * MiB;
constexpr size_t WL_G1 = 0, WL_G2 = 4 * MiB, WL_W1 = 10 * MiB, WL_W2 = 14 * MiB, WL_WO = 16 * MiB, WL_SP = 18 * MiB;
constexpr size_t WS_FGU = 48 * MiB, WS_FD = 54 * MiB;
constexpr size_t WS_SSQ1 = 57 * MiB, WS_SSQ2 = 62 * MiB, WS_DT = 65 * MiB;
constexpr size_t WS_TOKE = 74 * MiB, WS_TOKP = 75 * MiB, WS_TOKS = 76 * MiB, WS_CNTB = 77 * MiB;
constexpr size_t WS_SW = 77 * MiB + 256 * 1024;
constexpr int SW_L = NG1 + NG2, SW_FGU = 2 * SW_L, SW_MOE = SW_FGU + 2 * DFF;
constexpr size_t D_WMOE = 78 * MiB;
constexpr size_t WS_D = 162 * MiB;
#ifndef I8_IN
#define I8_IN I8_UP
#endif
constexpr int IN_MODE = I8_IN ? 2 : 0;
#ifndef I8_FFN
#define I8_FFN I8_UP
#endif
constexpr int UP_MODE = I8_FFN ? 2 : (FP8_FFN ? 1 : 0);
constexpr int DN_MODE = FP8_FFN ? 1 : 0;
constexpr int INESZ = IN_MODE ? 1 : 2, UPESZ = UP_MODE ? 1 : 2, FESZ = DN_MODE ? 1 : 2;
static_assert(IN_MODE == 2 && UP_MODE == 2 && DN_MODE == 1, "the workspace map below assumes int8 input/up projections and fp8 down projections");
constexpr size_t D_H = WS_D, D_XBC = WS_D + 34 * MiB, D_XT = WS_D + 238 * MiB, D_BT = WS_D + 374 * MiB, D_CM = WS_D + 408 * MiB, D_CB = WS_D + 442 * MiB;
constexpr size_t D_Y = WS_D + 34 * MiB, D_V = WS_D + 170 * MiB, D_G = WS_D + 238 * MiB, D_U = WS_D + 374 * MiB, D_MG = WS_D + 170 * MiB;
constexpr size_t D_H2 = WS_D, D_HD = WS_D + 238 * MiB;
constexpr size_t D_H2M = WS_D, D_H2S = WS_D + 32 * MiB, D_HDM = WS_D + 98 * MiB, D_O = WS_D + 217 * MiB;
constexpr size_t WS_NEED = WS_D + 476 * MiB;
constexpr size_t WMOE_UP = (size_t)2 * DFFE * DM * UPESZ, WMOE_E = WMOE_UP + (size_t)DM * DFFE * FESZ;
static_assert((size_t)T * 3072 * 2 <= 204 * MiB && (size_t)T * 2048 * 2 <= 136 * MiB && (size_t)T * 1024 * 2 <= 68 * MiB && (size_t)T * DM * INESZ <= 34 * MiB, "map");
static_assert((size_t)T * DFF * FESZ <= 136 * MiB && (size_t)MOE_MAXT * 256 * 2048 <= 132 * MiB && (size_t)MOE_HALF * 256 * DFFE * FESZ <= 119 * MiB && NE * WMOE_E <= 84 * MiB && (size_t)MOE_MAXT * 256 * DM * UPESZ <= 66 * MiB, "map2");
static_assert((size_t)NG1 * DM * INESZ <= 4 * MiB && (size_t)NG2 * DM * INESZ <= 6 * MiB && (size_t)2 * DFF * DM * UPESZ <= 6 * MiB && (size_t)DM * DFF * FESZ <= 3 * MiB, "map3");
constexpr int E8_ONE = 0x7F7F7F7F, E8_W = 0x79797979  , E8_HD = 0x7D7D7D7D  ;

constexpr int LDS_BYTES = 151552;
constexpr int LDS_MISC = 150528;

typedef __bf16 bf16x2_t __attribute__((ext_vector_type(2)));
__device__ __forceinline__ unsigned cvt_pk_bf16(float lo, float hi) { f32x2 v = {lo, hi}; bf16x2_t b = __builtin_convertvector(v, bf16x2_t); return __builtin_bit_cast(unsigned, b); }
__device__ __forceinline__ float fclamp127(float v) { return __builtin_fminf(__builtin_fmaxf(v, -127.f), 127.f); }
__device__ __forceinline__ float fclamp8(float v) { return __builtin_fminf(__builtin_fmaxf(v, -448.f), 448.f); }
__device__ __forceinline__ unsigned cvt_pk4_fp8(float a, float b, float c, float d) { int w = 0; w = __builtin_amdgcn_cvt_pk_fp8_f32(fclamp8(a), fclamp8(b), w, false); w = __builtin_amdgcn_cvt_pk_fp8_f32(fclamp8(c), fclamp8(d), w, true); return (unsigned)w; }
__device__ __forceinline__ float bf_lo(unsigned w) { return __uint_as_float(w << 16); }
__device__ __forceinline__ float bf_hi(unsigned w) { return __uint_as_float(w & 0xffff0000u); }
__device__ __forceinline__ float bf2f(bf16_t b) { return __uint_as_float(((unsigned)b) << 16); }
__device__ __forceinline__ bf16_t f2bf(float f) { return (bf16_t)(cvt_pk_bf16(f, 0.f) & 0xffffu); }
__device__ __forceinline__ float frcp(float x) { return __builtin_amdgcn_rcpf(x); }
__device__ __forceinline__ float fsigmoid(float x) { return frcp(1.0f + __expf(-x)); }
__device__ __forceinline__ float fsilu(float x) { return x * frcp(1.0f + __expf(-x)); }
__device__ __forceinline__ float fgelu(float x) { const float u = 1.5957691216057308f * (x + 0.044715f * x * x * x); return x * frcp(1.0f + __expf(-u)); }
__device__ __forceinline__ float fsoftplus(float x) {
    const float e = __expf(-__builtin_fabsf(x)); const float l = e < 0.0078125f ? e * (1.0f - e * (0.5f - e * 0.33333334f)) : __logf(1.0f + e); return __builtin_fmaxf(x, 0.f) + l; }
__device__ __forceinline__ float shx(float v, int mask, int lane) { return __int_as_float(__builtin_amdgcn_ds_bpermute((lane ^ mask) << 2, __float_as_int(v))); }
#define WR_DPP(v, ctrl, rmask, bc) __int_as_float(__builtin_amdgcn_update_dpp(0, __float_as_int(v), (ctrl), (rmask), 0xF, (bc)))
__device__ __forceinline__ float wave_max(float v, int lane) {
    (void)lane;
    v = __builtin_fmaxf(v, WR_DPP(v, 0x111, 0xF, true)); v = __builtin_fmaxf(v, WR_DPP(v, 0x112, 0xF, true)); v = __builtin_fmaxf(v, WR_DPP(v, 0x114, 0xF, true)); v = __builtin_fmaxf(v, WR_DPP(v, 0x118, 0xF, true));
    v = __builtin_fmaxf(v, WR_DPP(v, 0x142, 0xA, false)); v = __builtin_fmaxf(v, WR_DPP(v, 0x143, 0xC, false));
    return __int_as_float(__builtin_amdgcn_readlane(__float_as_int(v), 63));
}
__device__ __forceinline__ unsigned pack_i8x4(float a, float b, float c, float d, float inv) {
    const int ia = (int)__builtin_rintf(fclamp127(a * inv)), ib = (int)__builtin_rintf(fclamp127(b * inv)), ic = (int)__builtin_rintf(fclamp127(c * inv)), id = (int)__builtin_rintf(fclamp127(d * inv));
    return (unsigned)(ia & 255) | ((unsigned)(ib & 255) << 8) | ((unsigned)(ic & 255) << 16) | ((unsigned)id << 24);
}
__device__ __forceinline__ float wave_sum(float v, int lane) {
    (void)lane;
    v += WR_DPP(v, 0x111, 0xF, true); v += WR_DPP(v, 0x112, 0xF, true); v += WR_DPP(v, 0x114, 0xF, true); v += WR_DPP(v, 0x118, 0xF, true);
    v += WR_DPP(v, 0x142, 0xA, false); v += WR_DPP(v, 0x143, 0xC, false);
    return __int_as_float(__builtin_amdgcn_readlane(__float_as_int(v), 63));
}

#define XB_TMO      128
#define XB_XCNT(j)  (256  + 64 * (j))
#define XB_XSUB(j)  (1280 + 64 * (j))
#define XB_XGEN(j)  (2304 + 64 * (j))
#define XB_TOP      3328
#define XB_TOPGEN   3392
#define XCD_BAR_WORDS 3456
#define XB_SPIN_CAP (1u << 24)
__device__ __forceinline__ unsigned xb_ld(unsigned* p)              { return __hip_atomic_load(p, __ATOMIC_RELAXED, __HIP_MEMORY_SCOPE_AGENT); }
__device__ __forceinline__ unsigned xb_add(unsigned* p, unsigned v) { return __hip_atomic_fetch_add(p, v, __ATOMIC_RELAXED, __HIP_MEMORY_SCOPE_AGENT); }
__device__ __forceinline__ unsigned xb_xcc_id() { return (unsigned)__builtin_amdgcn_s_getreg((3 << 11) | 20) & 0xFu; }
#define XB_SPIN(cond, bar) do { unsigned _sp = 0; while (cond) { __builtin_amdgcn_s_sleep(1); \
    if ((++_sp & 255u) == 0u) { if (xb_ld(&(bar)[XB_TMO])) break; if (_sp > XB_SPIN_CAP) { atomicAdd(&(bar)[XB_TMO], 1u); break; } } } } while (0)
struct XcdBarrier { unsigned* bar; unsigned x; volatile LAS unsigned* st; };
__device__ __forceinline__ XcdBarrier xcd_barrier_post(unsigned* bar, volatile LAS unsigned* st) {
    XcdBarrier b; b.bar = bar; b.x = xb_xcc_id(); b.st = st;
    if (threadIdx.x == 0) (void)xb_add(&bar[XB_XCNT(b.x)], 1u);
    return b;
}
__device__ __forceinline__ void xcd_barrier_complete(unsigned* bar, unsigned x, unsigned& nloc, unsigned& nx) {
    const unsigned G = gridDim.x * gridDim.y * gridDim.z;
    unsigned sum, cnt, mine, sp = 0u;
    for (;;) {
        sum = 0u; cnt = 0u; mine = 0u;
#pragma unroll
        for (unsigned j = 0; j < 16; ++j) { const unsigned c = xb_ld(&bar[XB_XCNT(j)]); sum += c; cnt += (c > 0u) ? 1u : 0u; mine = (j == x) ? c : mine; }
        if (sum == G) break;
        __builtin_amdgcn_s_sleep(1);
        if ((++sp & 255u) == 0u) { if (xb_ld(&bar[XB_TMO])) break; if (sp > XB_SPIN_CAP) { atomicAdd(&bar[XB_TMO], 1u); break; } }
    }
    nloc = mine > 0u ? mine : 1u; nx = cnt > 0u ? cnt : 1u;
}
__device__ __forceinline__ void xcd_barrier(const XcdBarrier& b) {
    asm volatile("s_waitcnt vmcnt(0)" ::: "memory");
    __syncthreads();
    if (threadIdx.x == 0) {
        unsigned* bar = b.bar;
        __builtin_amdgcn_s_waitcnt(0);
        unsigned nloc = b.st[0], nx = b.st[1];
        if (nloc == 0u) { xcd_barrier_complete(bar, b.x, nloc, nx); b.st[0] = nloc; b.st[1] = nx; }
        const unsigned old = xb_add(&bar[XB_XSUB(b.x)], 1u);
        const unsigned gen = old / nloc;
        if (old + 1u == (gen + 1u) * nloc) {
            __builtin_amdgcn_fence(__ATOMIC_RELEASE, "agent");
            asm volatile("s_waitcnt vmcnt(0)" ::: "memory");
            const unsigned og = xb_add(&bar[XB_TOP], 1u);
            const unsigned tg = og / nx;
            if (og + 1u == (tg + 1u) * nx) xb_add(&bar[XB_TOPGEN], 1u);
            else XB_SPIN(xb_ld(&bar[XB_TOPGEN]) == tg, bar);
            __builtin_amdgcn_fence(__ATOMIC_ACQUIRE, "agent");
            xb_add(&bar[XB_XGEN(b.x)], 1u);
            asm volatile("s_waitcnt vmcnt(0)" ::: "memory");
        } else {
            XB_SPIN(xb_ld(&bar[XB_XGEN(b.x)]) == gen, bar);
            __builtin_amdgcn_fence(__ATOMIC_ACQUIRE, "agent");
            asm volatile("s_waitcnt vmcnt(0)" ::: "memory");
        }
    }
    __syncthreads();
}
namespace pg8 {
constexpr int BM = 256, BK = 64, HALF = 128, HTB = HALF * BK * 2, STAGE_BYTES = 8 * HTB, NXCD = 8, WGM = 8;
__host__ __device__ __forceinline__ int lds_byte(int r, int c) { const int st = (r >> 4) * 2 + (c >> 5), rr = r & 15, cc = c & 31, ob = rr * 64 + cc * 2; return st * 1024 + (ob ^ (((ob >> 9) & 1) << 5)); }
__host__ __device__ __forceinline__ void stage_rc(int b, int& R, int& C) { const int st = b / 1024, sb = b % 1024, swz = sb ^ (((sb >> 9) & 1) << 5); R = (st >> 1) * 16 + swz / 64; C = (st & 1) * 32 + (swz % 64) / 2; }
__host__ __device__ __forceinline__ int perm32(int rho) { const int n = rho >> 4, i = rho & 15; return 8 * (i >> 2) + 4 * n + (i & 3); }

struct Unit { int rt, pn, seg, last, lda, ldb, nt; const char* a; const char* b; };

struct Sched {
    int nM, nN, G, c, nseg, lat_only, tm0;
    const char* A0; const char* A1; const char* B0; const char* B1; int lda0, lda1, K0, K1;
    const int* tileE; size_t bstrideE; const LAS int* tileL = nullptr;
    template <int NSEG> __device__ __forceinline__ bool next(int j, Unit& u) const {
        const int jj = (NSEG == 2) ? (j >> 1) : j, seg = (NSEG == 2) ? (j & 1) : 0;
        const int nwg = nM * nN; const long L = (long)jj * G + c; if (L >= nwg) return false;
        int wgid = (int)L; { const int q = nwg / NXCD, r = nwg % NXCD, xcd = wgid % NXCD, off = wgid / NXCD; wgid = (xcd < r ? xcd * (q + 1) : r * (q + 1) + (xcd - r) * q) + off; }
        const int nig = WGM * nN, gid = wgid / nig, fm = gid * WGM, gsz = (nM - fm) < WGM ? (nM - fm) : WGM;
        const int tm = fm + ((wgid % nig) % gsz), pn = (wgid % nig) / gsz;
        int rt = tm0 + tm; if (lat_only) rt = (tm >> 4) * 17 + (tm & 15) + 1;
        u.rt = rt; u.pn = pn; u.seg = seg; u.last = (seg == NSEG - 1) ? 1 : 0;
        const int lda = seg ? lda1 : lda0, K = seg ? K1 : K0;
        u.a = (seg ? A1 : A0) + (size_t)rt * 256 * lda;
        const char* bb = seg ? B1 : B0; if (tileL) bb += (size_t)tileL[rt] * bstrideE; else if (tileE) bb += (size_t)tileE[rt] * bstrideE;
        u.b = bb + (size_t)pn * 256 * K; u.lda = lda; u.ldb = K; u.nt = K / 128;
        return true;
    }
};

typedef int i32x8 __attribute__((ext_vector_type(8)));
typedef int i32x4 __attribute__((ext_vector_type(4)));
template <class Epi, bool VAR_LD = false, int MODE = 0, bool ALIGN_EPI = true>
__device__ __forceinline__ void gemm_phase(LAS unsigned char* lds, int tid_in, const Sched& S, const Epi& E) {
    constexpr bool FP8 = (MODE == 1), I8 = (MODE == 2);
    const int tid = tid_in, wid = __builtin_amdgcn_readfirstlane(tid >> 6), lane = tid & 63, wr = wid >> 2, wc = wid & 3, fr = lane & 15, fq = lane >> 4;
#define PG8_VOFF(U, vA0_, vA1_, vB0_, vB1_) do { int t2_ = tid; asm volatile("" : "+v"(t2_)); int R_, C_; \
        stage_rc(t2_ * 16, R_, C_); { const int Rb_ = Epi::PERM ? ((R_ & ~31) + perm32(R_ & 31)) : R_; vA0_ = (unsigned)(R_ * (U).lda + C_ * 2); vB0_ = (unsigned)(Rb_ * (U).ldb + C_ * 2); } \
        stage_rc(t2_ * 16 + 8192, R_, C_); { const int Rb_ = Epi::PERM ? ((R_ & ~31) + perm32(R_ & 31)) : R_; vA1_ = (unsigned)(R_ * (U).lda + C_ * 2); vB1_ = (unsigned)(Rb_ * (U).ldb + C_ * 2); } } while (0)
    const size_t kstep = (size_t)(BK * 2);
    const unsigned ldsw = (unsigned)wid * 1024u;
    const int aoff = lds_byte(wr * 64 + fr, fq * 8), boff = lds_byte(wc * 32 + fr, fq * 8);
#define PG8_SA(b, h) (((b) * 2 + (h)) * HTB)
#define PG8_SB(b, h) ((4 + (b) * 2 + (h)) * HTB)
#define PG8_STAGE(bufoff, gbase, v0, v1) do { \
        __builtin_amdgcn_global_load_lds((const unsigned*)((const char*)(gbase) + (v0)), (LAS unsigned*)(lds + (bufoff) + ldsw), 16, 0, 0); \
        __builtin_amdgcn_global_load_lds((const unsigned*)((const char*)(gbase) + (v1)), (LAS unsigned*)(lds + (bufoff) + ldsw + 8192), 16, 0, 0); } while (0)
#define PG8_LD8(p0, p1) __builtin_shufflevector(*(const LAS i32x4*)(p0), *(const LAS i32x4*)(p1), 0, 1, 2, 3, 4, 5, 6, 7)
#define PG8_LDA(dst, b, h) do { _Pragma("unroll") for (int m = 0; m < 4; ++m) dst[m] = PG8_LD8(lds + PG8_SA(b, h) + aoff + m * 2048, lds + PG8_SA(b, h) + aoff + m * 2048 + 1024); } while (0)
#define PG8_LDB(dst, b, h) do { _Pragma("unroll") for (int n = 0; n < 2; ++n) dst[n] = PG8_LD8(lds + PG8_SB(b, h) + boff + n * 2048, lds + PG8_SB(b, h) + boff + n * 2048 + 1024); } while (0)
#define PG8_HALFI(x, k) __builtin_shufflevector((x), (x), 4 * (k), 4 * (k) + 1, 4 * (k) + 2, 4 * (k) + 3)
#define PG8_HALF(x, k) __builtin_bit_cast(bf16x8, __builtin_shufflevector((x), (x), 4 * (k), 4 * (k) + 1, 4 * (k) + 2, 4 * (k) + 3))
#define PG8_MMA(ai, bj, At, Bt) do { __builtin_amdgcn_s_setprio(1); if constexpr (FP8) { _Pragma("unroll") for (int m = 0; m < 4; ++m) _Pragma("unroll") for (int n = 0; n < 2; ++n) \
        asm volatile("v_mfma_scale_f32_16x16x128_f8f6f4 %0, %1, %2, %0, %3, %4 op_sel_hi:[0,0,0]" : "+v"(acc[ai][bj][m][n]) : "v"(Bt[n]), "v"(At[m]), "v"(sc_w), "v"(sc_x)); } \
      else if constexpr (I8) { _Pragma("unroll") for (int m = 0; m < 4; ++m) _Pragma("unroll") for (int n = 0; n < 2; ++n) { \
        i32x4 c_ = __builtin_bit_cast(i32x4, acc[ai][bj][m][n]); \
        c_ = __builtin_amdgcn_mfma_i32_16x16x64_i8(PG8_HALFI(Bt[n], 0), PG8_HALFI(At[m], 0), c_, 0, 0, 0); \
        c_ = __builtin_amdgcn_mfma_i32_16x16x64_i8(PG8_HALFI(Bt[n], 1), PG8_HALFI(At[m], 1), c_, 0, 0, 0); \
        acc[ai][bj][m][n] = __builtin_bit_cast(f32x4, c_); } } \
      else { _Pragma("unroll") for (int m = 0; m < 4; ++m) _Pragma("unroll") for (int n = 0; n < 2; ++n) { \
        acc[ai][bj][m][n] = __builtin_amdgcn_mfma_f32_16x16x32_bf16(PG8_HALF(Bt[n], 0), PG8_HALF(At[m], 0), acc[ai][bj][m][n], 0, 0, 0); \
        acc[ai][bj][m][n] = __builtin_amdgcn_mfma_f32_16x16x32_bf16(PG8_HALF(Bt[n], 1), PG8_HALF(At[m], 1), acc[ai][bj][m][n], 0, 0, 0); } } __builtin_amdgcn_s_setprio(0); } while (0)
#define PG8_WAIT_V(n) asm volatile("s_waitcnt vmcnt(" #n ")" ::: "memory")
#define PG8_WAIT_L(n) asm volatile("s_waitcnt lgkmcnt(" #n ")" ::: "memory")
#define PG8_BAR __builtin_amdgcn_s_barrier()
#define PG8_SCHED __builtin_amdgcn_sched_barrier(0)
    Unit cur, nxt; int ui = 0;
    int sc_w = 0, sc_x = 0; if constexpr (FP8) { sc_w = Epi::SCALE_W; sc_x = Epi::SCALE_X; asm volatile("" : "+v"(sc_w), "+v"(sc_x)); }
    constexpr int NSEG = VAR_LD ? 2 : 1;
    if (!S.template next<NSEG>(0, cur)) return;
    f32x4 acc[2][2][4][2];
#pragma unroll
    for (int a = 0; a < 2; ++a)
#pragma unroll
        for (int b = 0; b < 2; ++b)
#pragma unroll
            for (int m = 0; m < 4; ++m)
#pragma unroll
                for (int n = 0; n < 2; ++n) acc[a][b][m][n] = (f32x4){0.f, 0.f, 0.f, 0.f};
    i32x8 At[4], B0[2], B1[2];
    const char* cA = cur.a; const char* cB = cur.b;
    unsigned cvA0, cvA1, cvB0, cvB1; PG8_VOFF(cur, cvA0, cvA1, cvB0, cvB1);
    size_t chA = (size_t)HALF * cur.lda, chB = (size_t)HALF * cur.ldb;
    PG8_STAGE(PG8_SB(0, 0), cB, cvB0, cvB1); PG8_STAGE(PG8_SB(0, 1), cB + chB, cvB0, cvB1); PG8_STAGE(PG8_SA(0, 0), cA, cvA0, cvA1); PG8_STAGE(PG8_SA(0, 1), cA + chA, cvA0, cvA1);
    if (wr == 1) PG8_BAR;
    PG8_WAIT_V(2); PG8_BAR;
    PG8_STAGE(PG8_SB(1, 0), cB + kstep, cvB0, cvB1); PG8_STAGE(PG8_SA(1, 0), cA + kstep, cvA0, cvA1); PG8_STAGE(PG8_SB(1, 1), cB + chB + kstep, cvB0, cvB1);
    PG8_WAIT_V(6); PG8_BAR;
    for (;;) {
        const bool has_next = S.template next<NSEG>(ui + 1, nxt);
        if (!has_next) nxt = cur;
        const char* nA = nxt.a; const char* nB = nxt.b;
        unsigned nvA0 = cvA0, nvA1 = cvA1, nvB0 = cvB0, nvB1 = cvB1; size_t nhA = chA, nhB = chB;
        if constexpr (VAR_LD) { PG8_VOFF(nxt, nvA0, nvA1, nvB0, nvB1); nhA = (size_t)HALF * nxt.lda; nhB = (size_t)HALF * nxt.ldb; }
        const int nt = cur.nt;
        for (int t = 0; t < nt; t += 2) {
            const bool last = (t == nt - 2);
            const char* a1 = cA + (size_t)(t + 1) * kstep;
            const char* a2 = last ? nA : cA + (size_t)(t + 2) * kstep; const char* b2 = last ? nB : cB + (size_t)(t + 2) * kstep;
            const char* a3 = a2 + kstep; const char* b3 = b2 + kstep;
            const unsigned vA0 = last ? nvA0 : cvA0, vA1 = last ? nvA1 : cvA1, vB0 = last ? nvB0 : cvB0, vB1 = last ? nvB1 : cvB1;
            const size_t hA = last ? nhA : chA, hB = last ? nhB : chB;
            PG8_LDB(B0, 0, 0); PG8_LDB(B1, 0, 1); PG8_SCHED; PG8_LDA(At, 0, 0); PG8_STAGE(PG8_SA(1, 1), a1 + chA, cvA0, cvA1);
            PG8_WAIT_V(8); PG8_WAIT_L(0); PG8_BAR; PG8_MMA(0, 0, At, B0); PG8_MMA(0, 1, At, B1); PG8_BAR; PG8_SCHED;
            PG8_LDA(At, 0, 1); PG8_STAGE(PG8_SB(0, 0), b2, vB0, vB1); PG8_STAGE(PG8_SB(0, 1), b2 + hB, vB0, vB1); PG8_STAGE(PG8_SA(0, 0), a2, vA0, vA1);
            PG8_WAIT_V(8); PG8_WAIT_L(0); PG8_BAR; PG8_MMA(1, 0, At, B0); PG8_MMA(1, 1, At, B1); PG8_BAR; PG8_SCHED;
            PG8_LDB(B0, 1, 0); PG8_LDB(B1, 1, 1); PG8_SCHED; PG8_LDA(At, 1, 0); PG8_STAGE(PG8_SA(0, 1), a2 + hA, vA0, vA1);
            PG8_WAIT_V(8); PG8_WAIT_L(0); PG8_BAR; PG8_MMA(0, 0, At, B0); PG8_MMA(0, 1, At, B1); PG8_BAR; PG8_SCHED;
            PG8_LDA(At, 1, 1); PG8_STAGE(PG8_SB(1, 0), b3, vB0, vB1); PG8_STAGE(PG8_SB(1, 1), b3 + hB, vB0, vB1); PG8_STAGE(PG8_SA(1, 0), a3, vA0, vA1);
            PG8_WAIT_V(8); PG8_WAIT_L(0); PG8_BAR; PG8_MMA(1, 0, At, B0); PG8_MMA(1, 1, At, B1); PG8_BAR; PG8_SCHED;
        }
        { unsigned m_ = ~0u; asm volatile("" : "+s"(m_)); const int l2_ = (int)__builtin_amdgcn_mbcnt_hi(m_, __builtin_amdgcn_mbcnt_lo(m_, 0u));
            const typename Epi::Pre pre = E.prefetch(cur, wr, wc, l2_ & 15, l2_ >> 4);
            if constexpr (ALIGN_EPI) { if (wr == 0) PG8_BAR; }
            if constexpr (FP8) asm volatile("s_nop 15\n\ts_nop 15" ::: "memory");
            E(acc, cur, wr, wc, l2_ & 15, l2_ >> 4, pre); }
        if (!has_next) break;
        if (cur.last) {
#pragma unroll
            for (int a = 0; a < 2; ++a)
#pragma unroll
                for (int b = 0; b < 2; ++b)
#pragma unroll
                    for (int m = 0; m < 4; ++m)
#pragma unroll
                        for (int n = 0; n < 2; ++n) acc[a][b][m][n] = (f32x4){0.f, 0.f, 0.f, 0.f};
        }
        cur = nxt; cA = nA; cB = nB; cvA0 = nvA0; cvA1 = nvA1; cvB0 = nvB0; cvB1 = nvB1; chA = nhA; chB = nhB; ++ui;
        if constexpr (ALIGN_EPI) { if (wr == 1) PG8_BAR; }
    }
    PG8_WAIT_V(0);
    if constexpr (!ALIGN_EPI) { if (wr == 0) PG8_BAR; }
    PG8_BAR;
#undef PG8_VOFF
#undef PG8_SA
#undef PG8_SB
#undef PG8_STAGE
#undef PG8_LDA
#undef PG8_LDB
#undef PG8_MMA
#undef PG8_HALF
#undef PG8_HALFI
#undef PG8_LD8
#undef PG8_WAIT_V
#undef PG8_WAIT_L
#undef PG8_BAR
#undef PG8_SCHED
}
}
struct Params {
    const float* x; const float* c; const float* ctx; const float* c_ctx; const float* w_ada; const float* b_ada; const float* norm1_g; const float* w_in;
    const float* conv_w; const float* conv_b; const float* dt_bias; const float* a_log; const float* d_skip; const float* ssd_norm_g; const float* w_ssd_br;
    const float* gm_norm_g; const float* w_spatial; const float* b_spatial; const float* w_gm_br; const float* w_out; const float* norm2_g;
    const float* ffn_w_gate; const float* ffn_w_up; const float* ffn_w_down; const float* moe_router_w; const float* moe_router_b;
    const float* moe_w_gate; const float* moe_w_up; const float* moe_w_down; const float* final_norm_g;
    float* out; unsigned char* ws; int ph_lo, ph_hi;
};

struct Ctx {
    LAS unsigned char* lds; int tid, lane, wave, G, bid;
};

__device__ __forceinline__ const float* res_in_row(const Params& p, int state, int row) {
    const int b = row / TPB, i = row - b * TPB;
    if (i < CTXL) return (state ? (const float*)(p.ws + WS_CTXRES) : p.ctx) + (size_t)(b * CTXL + i) * DM;
    return (state ? (const float*)p.out : p.x) + (size_t)(b * SEQ + (i - CTXL)) * DM;
}
__device__ __forceinline__ float* res_out_row(const Params& p, int row) {
    const int b = row / TPB, i = row - b * TPB;
    if (i < CTXL) return (float*)(p.ws + WS_CTXRES) + (size_t)(b * CTXL + i) * DM;
    return p.out + (size_t)(b * SEQ + (i - CTXL)) * DM;
}
__device__ __forceinline__ const float* mod_vec(const Params& p, int layer, int row_tile, int k) {
    const int b = row_tile / 17, j = row_tile - b * 17; const int bm = (j == 0) ? 8 : b;
    return (const float*)(p.ws + WS_MOD) + ((size_t)(layer * 9 + bm) * 6 + k) * DM;
}

__device__ __forceinline__ void mod_unit(const Params& p, const Ctx& F, int unit) {
    const int layer = unit / 96, slab = unit - layer * 96;
    LAS float* sv = (LAS float*)F.lds;
    LAS float* red = (LAS float*)(F.lds + 9 * 1024 * 4);
    __syncthreads();
    for (int i = F.tid; i < 9 * 1024; i += 512) { const int r = i >> 10, k = i & 1023; const float v = (r < 8) ? p.c[r * DM + k] : p.c_ctx[k]; sv[i] = fsilu(v); }
    __syncthreads();
    const int cg = F.lane & 15, ks = F.wave * 4 + (F.lane >> 4);
    const float* W = p.w_ada + (size_t)layer * DM * 6144 + slab * 64 + cg * 4;
    f32x4 acc[9];
#pragma unroll
    for (int r = 0; r < 9; ++r) acc[r] = (f32x4){0.f, 0.f, 0.f, 0.f};
    for (int kk = 0; kk < 32; ++kk) {
        const int k = ks * 32 + kk;
        const f32x4 w = *(const f32x4*)(W + (size_t)k * 6144);
#pragma unroll
        for (int r = 0; r < 9; ++r) acc[r] += w * sv[r * 1024 + k];
    }
#pragma unroll
    for (int r = 0; r < 9; ++r)
#pragma unroll
        for (int j = 0; j < 4; ++j) { float v = acc[r][j]; v += shx(v, 16, F.lane); v += shx(v, 32, F.lane); acc[r][j] = v; }
    if (F.lane < 16) {
#pragma unroll
        for (int r = 0; r < 9; ++r)
#pragma unroll
            for (int j = 0; j < 4; ++j) red[(F.wave * 9 + r) * 64 + cg * 4 + j] = acc[r][j];
    }
    __syncthreads();
    for (int i = F.tid; i < 9 * 64; i += 512) {
        const int r = i >> 6, cidx = i & 63; float s = 0.f;
#pragma unroll
        for (int w = 0; w < 8; ++w) s += red[(w * 9 + r) * 64 + cidx];
        const int col = slab * 64 + cidx;
        ((float*)(p.ws + WS_MOD))[(size_t)(layer * 9 + r) * 6144 + col] = s + p.b_ada[layer * 6144 + col];
    }
}

struct CvtJob { const float* src; int ld, K, c0, ncols; bf16_t* dst; int drow0, inter; const float* gain; float f8scale; float* sw; };
__device__ __forceinline__ int cvt_job_ntiles(const CvtJob& J) { return J.sw ? (J.ncols / 64) : (J.K / 128) * (J.ncols / 64); }
__device__ __forceinline__ int cvt_drow(const CvtJob& J, int j0) { return J.inter ? ((j0 >> 7) * 256 + (j0 & 127) + (J.inter - 1) * 128) : (J.drow0 + j0); }
__device__ __forceinline__ void cvt_fetch(const Ctx& F, const float* src, int ld, int k0, int n0, f32x4 (&r)[4]) {
    const int kk = F.tid >> 4, n4 = (F.tid & 15) * 4;
#pragma unroll
    for (int h = 0; h < 4; ++h) r[h] = *(const f32x4*)(src + (size_t)(k0 + kk + 32 * h) * ld + n0 + n4);
}
__device__ __forceinline__ void cvt_to_lds(const Ctx& F, LAS float* tile, const f32x4 (&r)[4]) {
    const int kk = F.tid >> 4, n4 = (F.tid & 15) * 4;
#pragma unroll
    for (int h = 0; h < 4; ++h) { const int k = kk + h * 32; tile[k * 65 + n4] = r[h][0]; tile[k * 65 + n4 + 1] = r[h][1]; tile[k * 65 + n4 + 2] = r[h][2]; tile[k * 65 + n4 + 3] = r[h][3]; }
}
__device__ __forceinline__ void cvt_emit(const Ctx& F, const LAS float* tile, const CvtJob& J, int drow, int k0, float i8inv) {
    const int nn = F.tid >> 3, ks = (F.tid & 7) * 16; float v[16];
#pragma unroll
    for (int j = 0; j < 16; ++j) { v[j] = tile[(ks + j) * 65 + nn]; if (J.gain) v[j] *= J.gain[k0 + ks + j]; }
    if (J.sw) { *(u32x4*)((unsigned char*)J.dst + (size_t)(drow + nn) * J.K + k0 + ks) = (u32x4){pack_i8x4(v[0], v[1], v[2], v[3], i8inv), pack_i8x4(v[4], v[5], v[6], v[7], i8inv), pack_i8x4(v[8], v[9], v[10], v[11], i8inv), pack_i8x4(v[12], v[13], v[14], v[15], i8inv)}; }
    else if (J.f8scale != 0.f) { const float f = J.f8scale; *(u32x4*)((unsigned char*)J.dst + (size_t)(drow + nn) * J.K + k0 + ks) = (u32x4){cvt_pk4_fp8(v[0] * f, v[1] * f, v[2] * f, v[3] * f), cvt_pk4_fp8(v[4] * f, v[5] * f, v[6] * f, v[7] * f), cvt_pk4_fp8(v[8] * f, v[9] * f, v[10] * f, v[11] * f), cvt_pk4_fp8(v[12] * f, v[13] * f, v[14] * f, v[15] * f)}; }
    else { bf16_t* d = J.dst + (size_t)(drow + nn) * J.K + k0 + ks;
        *(u32x4*)d = (u32x4){cvt_pk_bf16(v[0], v[1]), cvt_pk_bf16(v[2], v[3]), cvt_pk_bf16(v[4], v[5]), cvt_pk_bf16(v[6], v[7])};
        *(u32x4*)(d + 8) = (u32x4){cvt_pk_bf16(v[8], v[9]), cvt_pk_bf16(v[10], v[11]), cvt_pk_bf16(v[12], v[13]), cvt_pk_bf16(v[14], v[15])}; }
}
__device__ __forceinline__ void cvt_run(const Ctx& F, const CvtJob& J, int first, int stride) {
    LAS float* tile = (LAS float*)F.lds;
    const int n = cvt_job_ntiles(J);
    if (first >= n) return;
    if (!J.sw) {
        const int nk = J.K / 128; f32x4 r[4];
        cvt_fetch(F, J.src, J.ld, (first % nk) * 128, J.c0 + (first / nk) * 64, r);
        for (int t = first; t < n; t += stride) {
            const int k0 = (t % nk) * 128, j0 = (t / nk) * 64, drow = cvt_drow(J, j0);
            __syncthreads();
            cvt_to_lds(F, tile, r);
            const int tn = t + stride; if (tn < n) cvt_fetch(F, J.src, J.ld, (tn % nk) * 128, J.c0 + (tn / nk) * 64, r);
            __syncthreads();
            cvt_emit(F, tile, J, drow, k0, 0.f);
        }
    } else {
        LAS float* red = tile + 128 * 65;
        const int kk = F.tid >> 4, n4 = (F.tid & 15) * 4, K = J.K;
        for (int t = first; t < n; t += stride) {
            const int n0 = J.c0 + t * 64, drow = cvt_drow(J, t * 64);
            f32x4 mx = (f32x4){0.f, 0.f, 0.f, 0.f};
#pragma unroll 32
            for (int k = kk; k < K; k += 32) { const f32x4 v = *(const f32x4*)(J.src + (size_t)k * J.ld + n0 + n4);
#pragma unroll
                for (int j = 0; j < 4; ++j) mx[j] = __builtin_fmaxf(mx[j], __builtin_fabsf(v[j])); }
            __syncthreads();
#pragma unroll
            for (int j = 0; j < 4; ++j) red[kk * 64 + n4 + j] = mx[j];
            __syncthreads();
            if (F.tid < 64) { float m = 0.f;
#pragma unroll
                for (int q = 0; q < 32; ++q) m = __builtin_fmaxf(m, red[q * 64 + F.tid]);
                const float scl = m > 0.f ? m * (1.0f / 127.f) : 1.0f; J.sw[drow + F.tid] = scl; red[2048 + F.tid] = 1.0f / scl; }
            f32x4 r[4]; cvt_fetch(F, J.src, J.ld, 0, n0, r);
            for (int k0 = 0; k0 < K; k0 += 128) {
                __syncthreads();
                cvt_to_lds(F, tile, r);
                if (k0 + 128 < K) cvt_fetch(F, J.src, J.ld, k0 + 128, n0, r);
                __syncthreads();
                cvt_emit(F, tile, J, drow, k0, red[2048 + (F.tid >> 3)]);
            }
        }
    }
}

constexpr int NJOB0 = 2 * 9 + 3;
__device__ __forceinline__ CvtJob prologue_job(const Params& p, int j) {
    CvtJob J{};
    if (j < 18) {
        const int l = j / 9, q = j - l * 9; unsigned char* wl = p.ws + WS_WL + (size_t)l * WL_STRIDE;
        const float* win = p.w_in + (size_t)l * DM * DIN;
        J.ld = DIN; J.K = DM; J.src = win; J.inter = 0; J.gain = nullptr;
        float* swl = (float*)(p.ws + WS_SW) + l * SW_L; if (I8_IN && q < 6) J.sw = (q < 2) ? swl : swl + NG1;
        switch (q) {
        case 0: J.c0 = OFF_XBC; J.ncols = DXBC; J.dst = (bf16_t*)(wl + WL_G1); J.drow0 = 0; break;
        case 1: J.c0 = OFF_DT; J.ncols = 64; J.dst = (bf16_t*)(wl + WL_G1); J.drow0 = 3072; break;
        case 2: J.c0 = 0; J.ncols = 2048; J.dst = (bf16_t*)(wl + WL_G2); J.drow0 = 0; break;
        case 3: J.c0 = OFF_GATE; J.ncols = 2048; J.dst = (bf16_t*)(wl + WL_G2); J.drow0 = 2048; break;
        case 4: J.c0 = OFF_U; J.ncols = 1024; J.dst = (bf16_t*)(wl + WL_G2); J.drow0 = 4096; break;
        case 5: J.c0 = OFF_V; J.ncols = 1024; J.dst = (bf16_t*)(wl + WL_G2); J.drow0 = 5120; break;
        case 6: J.src = p.w_ssd_br + (size_t)l * DSSD * DM; J.ld = DM; J.K = DSSD; J.c0 = 0; J.ncols = DM; J.dst = (bf16_t*)(wl + WL_W1); J.drow0 = 0; J.gain = p.ssd_norm_g + l * DSSD; break;
        case 7: J.src = p.w_gm_br + (size_t)l * DM * DM; J.ld = DM; J.K = DM; J.c0 = 0; J.ncols = DM; J.dst = (bf16_t*)(wl + WL_W2); J.drow0 = 0; break;
        default: J.src = p.w_out + (size_t)l * DM * DM; J.ld = DM; J.K = DM; J.c0 = 0; J.ncols = DM; J.dst = (bf16_t*)(wl + WL_WO); J.drow0 = 0; break;
        }
    } else if (j == 18) { J.src = p.ffn_w_gate; J.ld = DFF; J.K = DM; J.c0 = 0; J.ncols = DFF; J.dst = (bf16_t*)(p.ws + WS_FGU); J.drow0 = 0; J.inter = 1; J.gain = nullptr; J.f8scale = UP_MODE == 1 ? 64.f : 0.f; if (UP_MODE == 2) J.sw = (float*)(p.ws + WS_SW) + SW_FGU; }
    else if (j == 19) { J.src = p.ffn_w_up; J.ld = DFF; J.K = DM; J.c0 = 0; J.ncols = DFF; J.dst = (bf16_t*)(p.ws + WS_FGU); J.drow0 = 0; J.inter = 2; J.gain = nullptr; J.f8scale = UP_MODE == 1 ? 64.f : 0.f; if (UP_MODE == 2) J.sw = (float*)(p.ws + WS_SW) + SW_FGU; }
    else { J.src = p.ffn_w_down; J.ld = DM; J.K = DFF; J.c0 = 0; J.ncols = DM; J.dst = (bf16_t*)(p.ws + WS_FD); J.drow0 = 0; J.inter = 0; J.gain = nullptr; J.f8scale = DN_MODE == 1 ? 64.f : 0.f; }
    return J;
}
__device__ __forceinline__ void convert_jobs(const Params& p, const Ctx& F, int j0, int j1, int wid, int nw) {
    int base = 0;
    for (int j = j0; j < j1; ++j) {
        const CvtJob J = prologue_job(p, j); const int n = cvt_job_ntiles(J);
        cvt_run(F, J, (wid - base % nw + nw) % nw, nw);
        base += n;
    }
}
__device__ __forceinline__ void phase_prologue(const Params& p, const Ctx& F, bool with_l1) {
    for (int u = F.bid; u < 192; u += F.G) mod_unit(p, F, u);
    convert_jobs(p, F, 0, 9, F.bid, F.G); if (with_l1) convert_jobs(p, F, 9, 18, F.bid, F.G); convert_jobs(p, F, 18, NJOB0, F.bid, F.G);
    for (int l = 0; l < 2; ++l) {
        unsigned char* wl = p.ws + WS_WL + (size_t)l * WL_STRIDE;
        u32x4* z = (u32x4*)(wl + WL_G1 + (size_t)3136 * DM * INESZ);
        for (int i = F.bid * 512 + F.tid; i < 192 * DM * INESZ / 16; i += F.G * 512) z[i] = (u32x4){0u, 0u, 0u, 0u};
        if (I8_IN && F.bid == 0 && F.tid < 192) ((float*)(p.ws + WS_SW))[l * SW_L + 3136 + F.tid] = 1.0f;
        const float* sp = p.w_spatial + (size_t)l * 8 * 128 * 128; u32x2* d = (u32x2*)(wl + WL_SP);
        for (int i = F.bid * 512 + F.tid; i < 8 * 128 * 128 / 4; i += F.G * 512) { const f32x4 v = *(const f32x4*)(sp + (size_t)i * 4); d[i] = (u32x2){cvt_pk_bf16(v[0], v[1]), cvt_pk_bf16(v[2], v[3])}; }
    }
}
__device__ __forceinline__ void moe_weight_convert(const Params& p, const Ctx& F, int e_lo, int e_hi, int wid, int nw) {
    int base = 0;
    for (int j = 3 * e_lo; j < 3 * e_hi; ++j) {
        const int e = j / 3, q = j - e * 3; CvtJob J{};
        unsigned char* we = p.ws + D_WMOE + (size_t)e * WMOE_E;
        if (q == 0) { J.src = p.moe_w_gate + (size_t)e * DM * DFFE; J.ld = DFFE; J.K = DM; J.c0 = 0; J.ncols = DFFE; J.dst = (bf16_t*)we; J.inter = 1; J.f8scale = UP_MODE == 1 ? 64.f : 0.f; if (UP_MODE == 2) J.sw = (float*)(p.ws + WS_SW) + SW_MOE + e * 2 * DFFE; }
        else if (q == 1) { J.src = p.moe_w_up + (size_t)e * DM * DFFE; J.ld = DFFE; J.K = DM; J.c0 = 0; J.ncols = DFFE; J.dst = (bf16_t*)we; J.inter = 2; J.f8scale = UP_MODE == 1 ? 64.f : 0.f; if (UP_MODE == 2) J.sw = (float*)(p.ws + WS_SW) + SW_MOE + e * 2 * DFFE; }
        else { J.src = p.moe_w_down + (size_t)e * DFFE * DM; J.ld = DM; J.K = DFFE; J.c0 = 0; J.ncols = DM; J.dst = (bf16_t*)(we + WMOE_UP); J.drow0 = 0; J.inter = 0; J.f8scale = DN_MODE == 1 ? 64.f : 0.f; }
        J.gain = nullptr;
        const int n = cvt_job_ntiles(J);
        cvt_run(F, J, (wid - base % nw + nw) % nw, nw);
        base += n;
    }
}

__device__ __forceinline__ void phase_norm(const Params& p, const Ctx& F, int layer, int state, const float* g, int kshift, bf16_t* H, bool lat_only, int mode = 0, float* SA = nullptr) {
    (void)lat_only;
    const int nw = F.G * 8; int pr = F.bid * 8 + F.wave;
    if (2 * pr >= T) return;
    f32x4 gg[4];
#pragma unroll
    for (int q = 0; q < 4; ++q) gg[q] = *(const f32x4*)(g + q * 256 + F.lane * 4);
    f32x4 v[2][4], s1[4], s0[4], vn[2][4], s1n[4], s0n[4];
    { const float* xr = res_in_row(p, state, 2 * pr); const float* sh = mod_vec(p, layer, (2 * pr) >> 8, kshift); const float* sc = mod_vec(p, layer, (2 * pr) >> 8, kshift + 1);
#pragma unroll
      for (int q = 0; q < 4; ++q) { vn[0][q] = *(const f32x4*)(xr + q * 256 + F.lane * 4); vn[1][q] = *(const f32x4*)(xr + DM + q * 256 + F.lane * 4); s1n[q] = *(const f32x4*)(sc + q * 256 + F.lane * 4); s0n[q] = *(const f32x4*)(sh + q * 256 + F.lane * 4); } }
    for (; 2 * pr < T; pr += nw) {
#pragma unroll
        for (int q = 0; q < 4; ++q) { v[0][q] = vn[0][q]; v[1][q] = vn[1][q]; s1[q] = s1n[q]; s0[q] = s0n[q]; }
        const int rn = 2 * (pr + nw);
        if (rn < T) { const float* xr = res_in_row(p, state, rn); const float* sh = mod_vec(p, layer, rn >> 8, kshift); const float* sc = mod_vec(p, layer, rn >> 8, kshift + 1);
#pragma unroll
            for (int q = 0; q < 4; ++q) { vn[0][q] = *(const f32x4*)(xr + q * 256 + F.lane * 4); vn[1][q] = *(const f32x4*)(xr + DM + q * 256 + F.lane * 4); s1n[q] = *(const f32x4*)(sc + q * 256 + F.lane * 4); s0n[q] = *(const f32x4*)(sh + q * 256 + F.lane * 4); } }
        float ss[2] = {0.f, 0.f};
#pragma unroll
        for (int e = 0; e < 2; ++e)
#pragma unroll
            for (int q = 0; q < 4; ++q) ss[e] += v[e][q][0] * v[e][q][0] + v[e][q][1] * v[e][q][1] + v[e][q][2] * v[e][q][2] + v[e][q][3] * v[e][q][3];
        { ss[0] = wave_sum(ss[0], F.lane); ss[1] = wave_sum(ss[1], F.lane); }
        float am[2] = {0.f, 0.f};
#pragma unroll
        for (int e = 0; e < 2; ++e) { const float rs = rsqrtf(ss[e] * (1.0f / DM) + EPS);
#pragma unroll
            for (int q = 0; q < 4; ++q) {
                v[e][q] = v[e][q] * rs * gg[q] * (s1[q] + 1.0f) + s0[q];
                am[e] = __builtin_fmaxf(am[e], __builtin_fmaxf(__builtin_fmaxf(__builtin_fabsf(v[e][q][0]), __builtin_fabsf(v[e][q][1])), __builtin_fmaxf(__builtin_fabsf(v[e][q][2]), __builtin_fabsf(v[e][q][3]))));
            } }
        float inv[2] = {0.f, 0.f};
        if (mode == 2) {
            { am[0] = wave_max(am[0], F.lane); am[1] = wave_max(am[1], F.lane); }
#pragma unroll
            for (int e = 0; e < 2; ++e) { const float scl = am[e] > 0.f ? am[e] * (1.0f / 127.f) : 1.0f; inv[e] = 1.0f / scl; if (F.lane == 0) SA[2 * pr + e] = scl; }
        }
#pragma unroll
        for (int e = 0; e < 2; ++e)
#pragma unroll
            for (int q = 0; q < 4; ++q) {
                const int col = q * 256 + F.lane * 4; const f32x4 o = v[e][q]; const size_t row = (size_t)(2 * pr + e);
                if (mode == 2) *(unsigned*)((unsigned char*)H + row * DM + col) = pack_i8x4(o[0], o[1], o[2], o[3], inv[e]);
                else if (mode == 1) *(unsigned*)((unsigned char*)H + row * DM + col) = cvt_pk4_fp8(o[0], o[1], o[2], o[3]);
                else *(u32x2*)(H + row * DM + col) = (u32x2){cvt_pk_bf16(o[0], o[1]), cvt_pk_bf16(o[2], o[3])};
            }
    }
}
using pg8::Unit;
typedef int i32x4q __attribute__((ext_vector_type(4)));
struct ScalePre { f32x4 sw[2][2]; float sa[2][4]; };
struct NoPre {};
template <bool PERM> __device__ __forceinline__ ScalePre scale_fetch(const float* SA, const float* SW, int row0, int colbase) {
    ScalePre P;
#pragma unroll
    for (int bj = 0; bj < 2; ++bj)
#pragma unroll
        for (int n = 0; n < 2; ++n) P.sw[bj][n] = *(const f32x4*)(SW + colbase + bj * 128 + (PERM ? 4 : 16) * n);
#pragma unroll
    for (int ai = 0; ai < 2; ++ai)
#pragma unroll
        for (int m = 0; m < 4; ++m) P.sa[ai][m] = SA[row0 + ai * 128 + m * 16];
    return P;
}
__device__ __forceinline__ void dequant_acc(f32x4 (&acc)[2][2][4][2], const ScalePre& P) {
#pragma unroll
    for (int ai = 0; ai < 2; ++ai)
#pragma unroll
        for (int m = 0; m < 4; ++m) { const float sa = P.sa[ai][m];
#pragma unroll
            for (int bj = 0; bj < 2; ++bj)
#pragma unroll
                for (int n = 0; n < 2; ++n) { const i32x4q iv = __builtin_bit_cast(i32x4q, acc[ai][bj][m][n]);
                    acc[ai][bj][m][n] = __builtin_convertvector(iv, f32x4) * (P.sw[bj][n] * sa); } }
}
struct EpiG1 {
    static constexpr bool PERM = true;
    bf16_t* XBC; float* DT; const float* dt_bias; const float* SA; const float* SW;
    typedef ScalePre Pre;
    __device__ __forceinline__ Pre prefetch(const Unit& u, int wr, int wc, int fr, int fq) const { return scale_fetch<true>(SA, SW, u.rt * 256 + wr * 64 + fr, u.pn * 256 + wc * 32 + 8 * fq); }
    __device__ __forceinline__ void operator()(f32x4 (&acc)[2][2][4][2], const Unit& u, int wr, int wc, int fr, int fq, const Pre& pre) const {
        const int row0 = u.rt * 256 + wr * 64 + fr;
        if constexpr (IN_MODE == 2) dequant_acc(acc, pre);
        if (u.pn < 12) {
            const int col0 = u.pn * 256 + wc * 32 + 8 * fq;
#pragma unroll
            for (int ai = 0; ai < 2; ++ai)
#pragma unroll
                for (int m = 0; m < 4; ++m) { bf16_t* rowp = XBC + (size_t)(row0 + ai * 128 + m * 16) * DXBC + col0;
#pragma unroll
                    for (int bj = 0; bj < 2; ++bj) { const f32x4 v0 = acc[ai][bj][m][0], v1 = acc[ai][bj][m][1];
                        u32x4 w; w.x = cvt_pk_bf16(v0[0], v0[1]); w.y = cvt_pk_bf16(v0[2], v0[3]); w.z = cvt_pk_bf16(v1[0], v1[1]); w.w = cvt_pk_bf16(v1[2], v1[3]);
                        *(u32x4*)(rowp + bj * 128) = w; } }
        } else if (wc < 2) {
            const int c0 = wc * 32 + 8 * fq;
            const f32x4 b0 = *(const f32x4*)(dt_bias + c0), b1 = *(const f32x4*)(dt_bias + c0 + 4);
#pragma unroll
            for (int ai = 0; ai < 2; ++ai)
#pragma unroll
                for (int m = 0; m < 4; ++m) { float* rowp = DT + (size_t)(row0 + ai * 128 + m * 16) * 64 + c0;
                    f32x4 v0 = acc[ai][0][m][0] + b0, v1 = acc[ai][0][m][1] + b1;
#pragma unroll
                    for (int j = 0; j < 4; ++j) { v0[j] = fsoftplus(v0[j]); v1[j] = fsoftplus(v1[j]); }
                    *(f32x4*)rowp = v0; *(f32x4*)(rowp + 4) = v1; }
        }
    }
};
struct EpiG2 {
    static constexpr bool PERM = true;
    bf16_t* Y; bf16_t* Gt; bf16_t* U; bf16_t* V; float* SSQ1; float* SSQ2; const float* SA; const float* SW;
    typedef ScalePre Pre;
    __device__ __forceinline__ Pre prefetch(const Unit& u, int wr, int wc, int fr, int fq) const { return scale_fetch<true>(SA, SW, u.rt * 256 + wr * 64 + fr, u.pn * 256 + wc * 32 + 8 * fq); }
    __device__ __forceinline__ void operator()(f32x4 (&acc)[2][2][4][2], const Unit& u, int wr, int wc, int fr, int fq, const Pre& pre) const {
        const int row0 = u.rt * 256 + wr * 64 + fr; const int pn = u.pn;
        if constexpr (IN_MODE == 2) dequant_acc(acc, pre);
        const int kind = pn < 8 ? 0 : (pn < 16 ? 1 : (pn < 20 ? 2 : 3));
        bf16_t* base; int ld, colt; float* ssq = nullptr; int sld = 0, scol = 0;
        if (kind == 0) { base = Y; ld = DSSD; colt = pn * 256; ssq = SSQ1; sld = 32; scol = pn * 4 + wc; }
        else if (kind == 1) { base = Gt; ld = 2048; colt = (pn - 8) * 256; }
        else if (kind == 2) { base = U; ld = DM; colt = (pn - 16) * 256; }
        else { base = V; ld = DM; colt = (pn - 20) * 256; ssq = SSQ2; sld = 16; scol = (pn - 20) * 4 + wc; }
        const int col0 = colt + wc * 32 + 8 * fq;
#pragma unroll
        for (int ai = 0; ai < 2; ++ai) {
            u32x4 yall[4][2];
            if (kind == 0) {
#pragma unroll
                for (int m = 0; m < 4; ++m)
#pragma unroll
                    for (int bj = 0; bj < 2; ++bj) yall[m][bj] = *(const u32x4*)(base + (size_t)(row0 + ai * 128 + m * 16) * ld + col0 + bj * 128);
            }
#pragma unroll
            for (int m = 0; m < 4; ++m) {
                const int row = row0 + ai * 128 + m * 16; bf16_t* rowp = base + (size_t)row * ld + col0; float ss = 0.f;
#pragma unroll
                for (int bj = 0; bj < 2; ++bj) {
                    f32x4 v0 = acc[ai][bj][m][0], v1 = acc[ai][bj][m][1];
                    if (kind == 0) {
                        const u32x4 yv = yall[m][bj];
                        v0[0] = bf_lo(yv.x) * fsilu(v0[0]); v0[1] = bf_hi(yv.x) * fsilu(v0[1]); v0[2] = bf_lo(yv.y) * fsilu(v0[2]); v0[3] = bf_hi(yv.y) * fsilu(v0[3]);
                        v1[0] = bf_lo(yv.z) * fsilu(v1[0]); v1[1] = bf_hi(yv.z) * fsilu(v1[1]); v1[2] = bf_lo(yv.w) * fsilu(v1[2]); v1[3] = bf_hi(yv.w) * fsilu(v1[3]);
                    } else if (kind == 1) {
#pragma unroll
                        for (int j = 0; j < 4; ++j) { v0[j] = fsigmoid(v0[j]); v1[j] = fsigmoid(v1[j]); }
                    } else if (kind == 3) {
#pragma unroll
                        for (int j = 0; j < 4; ++j) { v0[j] = fgelu(v0[j]); v1[j] = fgelu(v1[j]); }
                    }
                    ss += (v0[0] * v0[0] + v0[1] * v0[1]) + (v0[2] * v0[2] + v0[3] * v0[3]) + (v1[0] * v1[0] + v1[1] * v1[1]) + (v1[2] * v1[2] + v1[3] * v1[3]);
                    u32x4 w; w.x = cvt_pk_bf16(v0[0], v0[1]); w.y = cvt_pk_bf16(v0[2], v0[3]); w.z = cvt_pk_bf16(v1[0], v1[1]); w.w = cvt_pk_bf16(v1[2], v1[3]);
                    *(u32x4*)(rowp + bj * 128) = w;
                }
                if (ssq) { ss += shx(ss, 16, fq * 16 + fr); ss += shx(ss, 32, fq * 16 + fr); if (fq == 0) ssq[(size_t)row * sld + scol] = ss; }
            }
        }
    }
};
struct EpiMerge {
    static constexpr bool PERM = true;
    const bf16_t* Gt; const float* SSQ1; bf16_t* MG;
    typedef NoPre Pre;
    __device__ __forceinline__ Pre prefetch(const Unit&, int, int, int, int) const { return Pre{}; }
    __device__ __forceinline__ void operator()(f32x4 (&acc)[2][2][4][2], const Unit& u, int wr, int wc, int fr, int fq, const Pre&) const {
        const int row0 = u.rt * 256 + wr * 64 + fr; const int col0 = u.pn * 256 + wc * 32 + 8 * fq;
#pragma unroll
        for (int ai = 0; ai < 2; ++ai)
#pragma unroll
            for (int m = 0; m < 4; ++m) {
                const int row = row0 + ai * 128 + m * 16;
                float r1 = 1.f;
                if (u.seg == 0) {
                    const f32x4 s0 = *(const f32x4*)(SSQ1 + (size_t)row * 32 + fq * 8), s1 = *(const f32x4*)(SSQ1 + (size_t)row * 32 + fq * 8 + 4);
                    float ss = (s0[0] + s0[1]) + (s0[2] + s0[3]) + (s1[0] + s1[1]) + (s1[2] + s1[3]);
                    ss += shx(ss, 16, fq * 16 + fr); ss += shx(ss, 32, fq * 16 + fr);
                    r1 = rsqrtf(ss * (1.0f / DSSD) + EPS);
                }
#pragma unroll
                for (int bj = 0; bj < 2; ++bj) {
                    const bf16_t* gp = Gt + (size_t)row * 2048 + col0 + bj * 128;
                    const u32x4 g1 = *(const u32x4*)(gp + 1024);
                    float g1f[8] = {bf_lo(g1.x), bf_hi(g1.x), bf_lo(g1.y), bf_hi(g1.y), bf_lo(g1.z), bf_hi(g1.z), bf_lo(g1.w), bf_hi(g1.w)};
                    if (u.seg == 0) {
                        const u32x4 g0 = *(const u32x4*)gp;
                        float g0f[8] = {bf_lo(g0.x), bf_hi(g0.x), bf_lo(g0.y), bf_hi(g0.y), bf_lo(g0.z), bf_hi(g0.z), bf_lo(g0.w), bf_hi(g0.w)};
#pragma unroll
                        for (int j = 0; j < 4; ++j) { acc[ai][bj][m][0][j] *= r1 * g0f[j] * frcp(g1f[j]); acc[ai][bj][m][1][j] *= r1 * g0f[4 + j] * frcp(g1f[4 + j]); }
                    } else {
                        f32x4 v0 = acc[ai][bj][m][0], v1 = acc[ai][bj][m][1];
#pragma unroll
                        for (int j = 0; j < 4; ++j) { v0[j] *= g1f[j]; v1[j] *= g1f[4 + j]; }
                        u32x4 w; w.x = cvt_pk_bf16(v0[0], v0[1]); w.y = cvt_pk_bf16(v0[2], v0[3]); w.z = cvt_pk_bf16(v1[0], v1[1]); w.w = cvt_pk_bf16(v1[2], v1[3]);
                        *(u32x4*)(MG + (size_t)row * DM + col0 + bj * 128) = w;
                    }
                }
            }
    }
};
template <int SW = 0x7F7F7F7F, int SX = 0x7F7F7F7F> struct EpiResT {
    static constexpr bool PERM = false; static constexpr int SCALE_W = SW, SCALE_X = SX;
    const float* xin_lat; const float* xin_ctx; float* xo_lat; float* xo_ctx; const float* mod; int layer, kgate;
    typedef NoPre Pre;
    __device__ __forceinline__ Pre prefetch(const Unit&, int, int, int, int) const { return Pre{}; }
    __device__ __forceinline__ void operator()(f32x4 (&acc)[2][2][4][2], const Unit& u, int wr, int wc, int fr, int fq, const Pre&) const {
        const int b = u.rt / 17, j = u.rt - b * 17; const int bm = (j == 0) ? 8 : b;
        const size_t rbase = (j == 0) ? (size_t)(b * CTXL) : (size_t)(b * SEQ + (j - 1) * 256);
        const float* xi = ((j == 0) ? xin_ctx : xin_lat) + rbase * DM; float* xo = ((j == 0) ? xo_ctx : xo_lat) + rbase * DM;
        const float* gate = mod + ((size_t)(layer * 9 + bm) * 6 + kgate) * DM;
        const int r0 = wr * 64 + fr, col0 = u.pn * 256 + wc * 32 + 4 * fq;
        f32x4 gv[2][2];
#pragma unroll
        for (int bj = 0; bj < 2; ++bj)
#pragma unroll
            for (int n = 0; n < 2; ++n) gv[bj][n] = *(const f32x4*)(gate + col0 + bj * 128 + n * 16);
#pragma unroll
        for (int ai = 0; ai < 2; ++ai) {
            f32x4 bs[4][2][2];
#pragma unroll
            for (int m = 0; m < 4; ++m)
#pragma unroll
                for (int bj = 0; bj < 2; ++bj)
#pragma unroll
                    for (int n = 0; n < 2; ++n) bs[m][bj][n] = *(const f32x4*)(xi + (size_t)(r0 + ai * 128 + m * 16) * DM + col0 + bj * 128 + n * 16);
#pragma unroll
            for (int m = 0; m < 4; ++m)
#pragma unroll
                for (int bj = 0; bj < 2; ++bj)
#pragma unroll
                    for (int n = 0; n < 2; ++n) *(f32x4*)(xo + (size_t)(r0 + ai * 128 + m * 16) * DM + col0 + bj * 128 + n * 16) = bs[m][bj][n] + gv[bj][n] * acc[ai][bj][m][n];
        }
    }
};
typedef EpiResT<> EpiRes;
template <bool F8> struct EpiGluT {
    static constexpr bool PERM = true; static constexpr int SCALE_W = E8_W, SCALE_X = E8_ONE;
    bf16_t* HD; int ld, rt0; const float* SA; const float* SW; const int* tileE; const char* B0;
    typedef ScalePre Pre;
    __device__ __forceinline__ Pre prefetch(const Unit& u, int wr, int wc, int fr, int fq) const { const float* sw = SW; if (tileE) { const size_t e = (size_t)(u.b - B0 - (size_t)u.pn * 256 * (size_t)u.ldb) / WMOE_E; sw = SW + e * 2 * DFFE; }
        return scale_fetch<true>(SA, sw, u.rt * 256 + wr * 64 + fr, u.pn * 256 + wc * 32 + 8 * fq); }
    __device__ __forceinline__ void operator()(f32x4 (&acc)[2][2][4][2], const Unit& u, int wr, int wc, int fr, int fq, const Pre& pre) const {
        const int row0 = (u.rt - rt0) * 256 + wr * 64 + fr, col0 = u.pn * 128 + wc * 32 + 8 * fq;
        if constexpr (UP_MODE == 2) dequant_acc(acc, pre);
#pragma unroll
        for (int ai = 0; ai < 2; ++ai)
#pragma unroll
            for (int m = 0; m < 4; ++m) {
                const f32x4 g0 = acc[ai][0][m][0], g1 = acc[ai][0][m][1], u0 = acc[ai][1][m][0], u1 = acc[ai][1][m][1]; f32x4 v0, v1;
#pragma unroll
                for (int j = 0; j < 4; ++j) { v0[j] = fsilu(g0[j]) * u0[j]; v1[j] = fsilu(g1[j]) * u1[j]; }
                if constexpr (F8) { *(u32x2*)((unsigned char*)HD + (size_t)(row0 + ai * 128 + m * 16) * ld + col0) = (u32x2){cvt_pk4_fp8(4.f * v0[0], 4.f * v0[1], 4.f * v0[2], 4.f * v0[3]), cvt_pk4_fp8(4.f * v1[0], 4.f * v1[1], 4.f * v1[2], 4.f * v1[3])}; }
                else { u32x4 w; w.x = cvt_pk_bf16(v0[0], v0[1]); w.y = cvt_pk_bf16(v0[2], v0[3]); w.z = cvt_pk_bf16(v1[0], v1[1]); w.w = cvt_pk_bf16(v1[2], v1[3]);
                *(u32x4*)(HD + (size_t)(row0 + ai * 128 + m * 16) * ld + col0) = w; }
            }
    }
};
typedef EpiGluT<FP8_FFN != 0> EpiGlu;
struct EpiBf {
    static constexpr bool PERM = true; static constexpr int SCALE_W = E8_W, SCALE_X = E8_HD;
    bf16_t* O; int ld;
    typedef NoPre Pre;
    __device__ __forceinline__ Pre prefetch(const Unit&, int, int, int, int) const { return Pre{}; }
    __device__ __forceinline__ void operator()(f32x4 (&acc)[2][2][4][2], const Unit& u, int wr, int wc, int fr, int fq, const Pre&) const {
        const int row0 = u.rt * 256 + wr * 64 + fr, col0 = u.pn * 256 + wc * 32 + 8 * fq;
#pragma unroll
        for (int ai = 0; ai < 2; ++ai)
#pragma unroll
            for (int m = 0; m < 4; ++m) { bf16_t* rowp = O + (size_t)(row0 + ai * 128 + m * 16) * ld + col0;
#pragma unroll
                for (int bj = 0; bj < 2; ++bj) { const f32x4 v0 = acc[ai][bj][m][0], v1 = acc[ai][bj][m][1];
                    u32x4 w; w.x = cvt_pk_bf16(v0[0], v0[1]); w.y = cvt_pk_bf16(v0[2], v0[3]); w.z = cvt_pk_bf16(v1[0], v1[1]); w.w = cvt_pk_bf16(v1[2], v1[3]);
                    *(u32x4*)(rowp + bj * 128) = w; } }
    }
};
#define MFMA32(a, b, c) __builtin_amdgcn_mfma_f32_32x32x16_bf16((a), (b), (c), 0, 0, 0)
constexpr int PITCH = 272;

__device__ __forceinline__ u32x4 conv_fetch(const bf16_t* XBC, int cc, int colbase, int id) {
    const int c = cc % NCB, j = id >> 4, q = id & 15, l = j - 2;
    const bool valid = (l >= 0 && l < CHK) || (c == 0 && l >= CHK) || (c == 1 && l < 0);
    u32x4 v = (u32x4){0u, 0u, 0u, 0u};
    if (valid) v = *(const u32x4*)(XBC + (size_t)(cc * CHK + l) * DXBC + colbase + q * 8);
    return v;
}
__device__ __forceinline__ bool conv_tap_ok(bool is_ctx, int l, int d) { return is_ctx || (((l + d - 2) >> 6) == (l >> 6)); }

__device__ __forceinline__ void conv_xs_compute(const Params& p, const Ctx& F, int layer, int cc, int s, const float (&w6)[6]) {
    (void)layer;
    bf16_t* XT = (bf16_t*)(p.ws + D_XT);
    LAS unsigned char* raw = F.lds; LAS unsigned char* stg = F.lds + 34816;
    const bool is_ctx = (cc % NCB) < 2;
    const int col = F.tid & 127;
    float w[5];
#pragma unroll
    for (int d = 0; d < 5; ++d) w[d] = w6[d];
    const float bias = w6[5];
#pragma unroll
    for (int k = 0; k < 4; ++k) {
        const int run = (F.tid >> 7) + 4 * k, l0 = run * 8;
        float in[12];
#pragma unroll
        for (int i = 0; i < 12; ++i) in[i] = bf2f(*(const LAS bf16_t*)(raw + (l0 + i) * 256 + col * 2));
        float o[8];
#pragma unroll
        for (int i = 0; i < 8; ++i) { float a = bias;
#pragma unroll
            for (int d = 0; d < 5; ++d) a += conv_tap_ok(is_ctx, l0 + i, d) ? w[d] * in[i + d] : 0.f;
            o[i] = fsilu(a); }
        u32x4 wv; wv.x = cvt_pk_bf16(o[0], o[1]); wv.y = cvt_pk_bf16(o[2], o[3]); wv.z = cvt_pk_bf16(o[4], o[5]); wv.w = cvt_pk_bf16(o[6], o[7]);
        *(LAS u32x4*)(stg + col * PITCH + l0 * 2) = wv;
    }
    __syncthreads();
    bf16_t* blk = XT + (size_t)(cc * NH + 2 * s) * HDIM * CHK;
#pragma unroll
    for (int k = 0; k < 4; ++k) { const int id = F.tid + 512 * k; *(u32x4*)(blk + (size_t)id * 8) = *(const LAS u32x4*)(stg + (id >> 4) * PITCH + (id & 15) * 16); }
}
constexpr int BC_RAWB = 0, BC_RAWC = 33792, BC_B = 67584, BC_C = 102400, BC_W = 137216;
__device__ __forceinline__ void conv_bc_compute(const Params& p, const Ctx& F, int cc, int g) {
    bf16_t* BT = (bf16_t*)(p.ws + D_BT) + (size_t)(cc * NGRP + g) * CHK * NST; bf16_t* CM = (bf16_t*)(p.ws + D_CM) + (size_t)(cc * NGRP + g) * CHK * NST; bf16_t* CB = (bf16_t*)(p.ws + D_CB) + (size_t)(cc * NGRP + g) * CHK * CHK;
    LAS unsigned char* Bc = F.lds + BC_B; LAS unsigned char* Cc = F.lds + BC_C; LAS float* W = (LAS float*)(F.lds + BC_W);
    const bool is_ctx = (cc % NCB) < 2;
#pragma unroll 2
    for (int k = 0; k < 8; ++k) {
        const int task = F.tid + 512 * k, mat = task >> 11, t2 = task & 2047, l = t2 >> 4, q = t2 & 15;
        LAS unsigned char* raw = F.lds + (mat ? BC_RAWC : BC_RAWB); const int wc = mat * 128 + q * 8;
        float a[8];
        { const f32x4 b0 = *(const LAS f32x4*)(W + 5 * 256 + wc), b1 = *(const LAS f32x4*)(W + 5 * 256 + wc + 4); a[0] = b0[0]; a[1] = b0[1]; a[2] = b0[2]; a[3] = b0[3]; a[4] = b1[0]; a[5] = b1[1]; a[6] = b1[2]; a[7] = b1[3]; }
#pragma unroll
        for (int d = 0; d < 5; ++d) {
            if (conv_tap_ok(is_ctx, l, d)) {
                const u32x4 v = *(const LAS u32x4*)(raw + (l + d) * 256 + q * 16);
                const f32x4 w0 = *(const LAS f32x4*)(W + d * 256 + wc), w1 = *(const LAS f32x4*)(W + d * 256 + wc + 4);
                a[0] += w0[0] * bf_lo(v.x); a[1] += w0[1] * bf_hi(v.x); a[2] += w0[2] * bf_lo(v.y); a[3] += w0[3] * bf_hi(v.y);
                a[4] += w1[0] * bf_lo(v.z); a[5] += w1[1] * bf_hi(v.z); a[6] += w1[2] * bf_lo(v.w); a[7] += w1[3] * bf_hi(v.w);
            }
        }
        u32x4 wv; wv.x = cvt_pk_bf16(fsilu(a[0]), fsilu(a[1])); wv.y = cvt_pk_bf16(fsilu(a[2]), fsilu(a[3])); wv.z = cvt_pk_bf16(fsilu(a[4]), fsilu(a[5])); wv.w = cvt_pk_bf16(fsilu(a[6]), fsilu(a[7]));
        *(LAS u32x4*)((mat ? Cc : Bc) + l * PITCH + q * 16) = wv;
        if (mat) *(u32x4*)(CM + (size_t)l * NST + q * 8) = wv;
    }
    __syncthreads();
#pragma unroll
    for (int k = 0; k < 4; ++k) {
        const int task = F.tid + 512 * k, n = task & 127, l0 = (task >> 7) * 8; unsigned short e[8];
#pragma unroll
        for (int i = 0; i < 8; ++i) e[i] = *(const LAS bf16_t*)(Bc + (l0 + i) * PITCH + n * 2);
        u32x4 wv; wv.x = e[0] | ((unsigned)e[1] << 16); wv.y = e[2] | ((unsigned)e[3] << 16); wv.z = e[4] | ((unsigned)e[5] << 16); wv.w = e[6] | ((unsigned)e[7] << 16);
        *(u32x4*)(BT + (size_t)n * CHK + l0) = wv;
    }
    const int r = F.lane & 31, hh = F.lane >> 5;
#pragma unroll
    for (int tt = 0; tt < 2; ++tt) {
        const int t = F.wave * 2 + tt, si = t >> 2, li = t & 3;
        f32x16 acc; for (int i = 0; i < 16; ++i) acc[i] = 0.f;
#pragma unroll
        for (int ks = 0; ks < 8; ++ks) {
            const bf16x8 a = *(const LAS bf16x8*)(Bc + (si * 32 + r) * PITCH + ks * 32 + hh * 16);
            const bf16x8 b = *(const LAS bf16x8*)(Cc + (li * 32 + r) * PITCH + ks * 32 + hh * 16);
            acc = MFMA32(a, b, acc);
        }
#pragma unroll
        for (int m = 0; m < 2; ++m) {
            u32x2 a = (u32x2){cvt_pk_bf16(acc[8 * m], acc[8 * m + 1]), cvt_pk_bf16(acc[8 * m + 2], acc[8 * m + 3])}, bq = (u32x2){cvt_pk_bf16(acc[8 * m + 4], acc[8 * m + 5]), cvt_pk_bf16(acc[8 * m + 6], acc[8 * m + 7])};
            { auto t2 = __builtin_amdgcn_permlane32_swap(a.x, bq.x, false, false); a.x = t2[0]; bq.x = t2[1]; }
            { auto t2 = __builtin_amdgcn_permlane32_swap(a.y, bq.y, false, false); a.y = t2[0]; bq.y = t2[1]; }
            const int j = (2 * si + m - 2 * li) & 7;
            *(u32x4*)(CB + ((size_t)(li * 8 + j) * 64 + F.lane) * 8) = (u32x4){a.x, a.y, bq.x, bq.y};
        }
    }
}
__device__ __forceinline__ void phase_conv(const Params& p, const Ctx& F, int layer) {
    const bf16_t* XBC = (const bf16_t*)(p.ws + D_XBC);
    const float* cw = p.conv_w + (size_t)layer * 5 * DXBC; const float* cb = p.conv_b + (size_t)layer * DXBC;
    {
        const int n_bc = NCHUNK * NGRP;
        u32x4 pre[9]; float wpre[3];
        int u = F.bid;
        if (u < n_bc) {
#pragma unroll
            for (int j = 0; j < 9; ++j) { const int id = F.tid + 512 * j; pre[j] = (id < 4224) ? conv_fetch(XBC, u >> 2, (id >= 2112 ? 2560 : 2048) + (u & 3) * 128, id >= 2112 ? id - 2112 : id) : (u32x4){0u, 0u, 0u, 0u}; }
#pragma unroll
            for (int j = 0; j < 3; ++j) { const int id = F.tid + 512 * j, d = id >> 8, cidx = id & 255; const int gcol = (cidx >= 128 ? 2560 + cidx - 128 : 2048 + cidx) + (u & 3) * 128; wpre[j] = d < 5 ? cw[d * DXBC + gcol] : cb[gcol]; }
        }
        for (; u < n_bc; u += F.G) {
            __syncthreads();
#pragma unroll
            for (int j = 0; j < 9; ++j) { const int id = F.tid + 512 * j; if (id < 4224) *(LAS u32x4*)(F.lds + (id >= 2112 ? BC_RAWC + (id - 2112) * 16 : BC_RAWB + id * 16)) = pre[j]; }
#pragma unroll
            for (int j = 0; j < 3; ++j) ((LAS float*)(F.lds + BC_W))[F.tid + 512 * j] = wpre[j];
            const int un = u + F.G;
            if (un < n_bc) {
#pragma unroll
                for (int j = 0; j < 9; ++j) { const int id = F.tid + 512 * j; pre[j] = (id < 4224) ? conv_fetch(XBC, un >> 2, (id >= 2112 ? 2560 : 2048) + (un & 3) * 128, id >= 2112 ? id - 2112 : id) : (u32x4){0u, 0u, 0u, 0u}; }
#pragma unroll
                for (int j = 0; j < 3; ++j) { const int id = F.tid + 512 * j, d = id >> 8, cidx = id & 255; const int gcol = (cidx >= 128 ? 2560 + cidx - 128 : 2048 + cidx) + (un & 3) * 128; wpre[j] = d < 5 ? cw[d * DXBC + gcol] : cb[gcol]; }
            }
            __syncthreads();
            conv_bc_compute(p, F, u >> 2, u & 3);
        }
    }
    {
        const int n_xs = NCHUNK * 16;
        u32x4 pre[5];
        float w6[6] = {0.f, 0.f, 0.f, 0.f, 0.f, 0.f}; int s_loaded = -1;
        int v = F.G - 1 - F.bid;
        if (v < n_xs) {
#pragma unroll
            for (int j = 0; j < 5; ++j) { const int id = F.tid + 512 * j; pre[j] = (id < 2112) ? conv_fetch(XBC, v >> 4, (v & 15) * 128, id) : (u32x4){0u, 0u, 0u, 0u}; }
        }
        for (; v < n_xs; v += F.G) {
            __syncthreads();
#pragma unroll
            for (int j = 0; j < 5; ++j) { const int id = F.tid + 512 * j; if (id < 2112) *(LAS u32x4*)(F.lds + id * 16) = pre[j]; }
            const int vn = v + F.G;
            if (vn < n_xs) {
#pragma unroll
                for (int j = 0; j < 5; ++j) { const int id = F.tid + 512 * j; pre[j] = (id < 2112) ? conv_fetch(XBC, vn >> 4, (vn & 15) * 128, id) : (u32x4){0u, 0u, 0u, 0u}; }
            }
            __syncthreads();
            if ((v & 15) != s_loaded) { s_loaded = v & 15; const int gc = s_loaded * 128 + (F.tid & 127);
#pragma unroll
                for (int d = 0; d < 5; ++d) w6[d] = cw[d * DXBC + gc];
                w6[5] = cb[gc]; }
            conv_xs_compute(p, F, layer, v >> 4, v & 15, w6);
        }
    }
}

__device__ __forceinline__ void gmlp_vmap(int t, int& sp, int& q) { const int lane = t & 63, w = t >> 6; sp = (w & 7) * 16 + (lane & 15); q = (w >> 3) * 4 + (lane >> 4); }
__device__ __forceinline__ void phase_gmlp(const Params& p, const Ctx& F, int layer, bool lat_only, bool dry = false) {
    const bf16_t* V = (const bf16_t*)(p.ws + D_V); bf16_t* U = (bf16_t*)(p.ws + D_U); const float* SSQ2 = (const float*)(p.ws + WS_SSQ2);
    LAS unsigned char* VT = F.lds; LAS float* rrb = (LAS float*)(F.lds + 34816);
    const int r = F.lane & 31, hh = F.lane >> 5;
    auto unit_ok = [&](int u) { return !(lat_only && ((u >> 3) % NCB) < 2); };
    int u = F.bid; while (u < NCHUNK * 8 && !unit_ok(u)) u += F.G;
    u32x4 pre[4]; f32x4 spre = (f32x4){0.f, 0.f, 0.f, 0.f};
    int it = 0;
    if (u < NCHUNK * 8) {
        const int cc = u >> 3, g = u & 7;
#pragma unroll
        for (int k = 0; k < 4; ++k) { int sp, q; gmlp_vmap(F.tid + 512 * k, sp, q); pre[k] = *(const u32x4*)(V + (size_t)(cc * CHK + sp) * DM + g * 128 + q * 8); }
        spre = *(const f32x4*)(SSQ2 + (size_t)(cc * CHK + (F.tid >> 2)) * 16 + (F.tid & 3) * 4);
        float a = (spre[0] + spre[1]) + (spre[2] + spre[3]); a += shx(a, 1, F.lane); a += shx(a, 2, F.lane);
        __syncthreads();
        if ((F.tid & 3) == 0) rrb[F.tid >> 2] = rsqrtf(a * (1.0f / DM) + EPS);
    }
    for (; u < NCHUNK * 8; ++it) {
        const int cc = u >> 3, g = u & 7;
        int un = u + F.G; while (un < NCHUNK * 8 && !unit_ok(un)) un += F.G;
        LAS float* rr = rrb + (it & 1) * 128; LAS float* rrn = rrb + ((it + 1) & 1) * 128;
        const bf16_t* WSP = (const bf16_t*)(p.ws + WS_WL + (size_t)layer * WL_STRIDE + WL_SP) + (size_t)g * CHK * CHK;
        const float* gmg = p.gm_norm_g + layer * DM + g * 128;
        __syncthreads();
#pragma unroll
        for (int k = 0; k < 4; ++k) {
            int sp, q; gmlp_vmap(F.tid + 512 * k, sp, q);
            const u32x4 v = pre[k]; const float rs = rr[sp]; const f32x4 g0 = *(const f32x4*)(gmg + q * 8), g1 = *(const f32x4*)(gmg + q * 8 + 4);
            const float f[8] = {bf_lo(v.x) * rs * g0[0], bf_hi(v.x) * rs * g0[1], bf_lo(v.y) * rs * g0[2], bf_hi(v.y) * rs * g0[3], bf_lo(v.z) * rs * g1[0], bf_hi(v.z) * rs * g1[1], bf_lo(v.w) * rs * g1[2], bf_hi(v.w) * rs * g1[3]};
#pragma unroll
            for (int e = 0; e < 8; ++e) *(LAS bf16_t*)(VT + (q * 8 + e) * PITCH + sp * 2) = f2bf(f[e]);
        }
        if (un < NCHUNK * 8) {
            const int ccn = un >> 3, gn = un & 7;
#pragma unroll
            for (int k = 0; k < 4; ++k) { int sp, q; gmlp_vmap(F.tid + 512 * k, sp, q); pre[k] = *(const u32x4*)(V + (size_t)(ccn * CHK + sp) * DM + gn * 128 + q * 8); }
            spre = *(const f32x4*)(SSQ2 + (size_t)(ccn * CHK + (F.tid >> 2)) * 16 + (F.tid & 3) * 4);
        }
        __syncthreads();
        const float* bsp = p.b_spatial + (size_t)layer * 8 * CHK + g * CHK;
#pragma unroll
        for (int tt = 0; tt < 2; ++tt) {
            const int t = F.wave * 2 + tt, ci = t >> 2, ti = t & 3;
            f32x16 acc; for (int i = 0; i < 16; ++i) acc[i] = 0.f;
            const bf16_t* wrow = WSP + (size_t)(ti * 32 + r) * CHK + hh * 8;
#pragma unroll
            for (int ks = 0; ks < 8; ++ks) {
                const bf16x8 a = *(const LAS bf16x8*)(VT + (ci * 32 + r) * PITCH + ks * 32 + hh * 16);
                const bf16x8 b = *(const bf16x8*)(wrow + ks * 16);
                acc = MFMA32(a, b, acc);
            }
            const int tpos = ti * 32 + r; const float bb = bsp[tpos];
            bf16_t* urow = U + (size_t)(cc * CHK + tpos) * DM + g * 128 + ci * 32 + 8 * hh;
#pragma unroll
            for (int kk = 0; kk < 2; ++kk) {
                const u32x4 uw = *(const u32x4*)(urow + 16 * kk);
                u32x2 ua = (u32x2){uw.x, uw.y}, ub = (u32x2){uw.z, uw.w};
                { auto t2 = __builtin_amdgcn_permlane32_swap(ua.x, ub.x, false, false); ua.x = t2[0]; ub.x = t2[1]; }
                { auto t2 = __builtin_amdgcn_permlane32_swap(ua.y, ub.y, false, false); ua.y = t2[0]; ub.y = t2[1]; }
                const int q0 = 2 * kk, q1 = 2 * kk + 1;
                u32x2 na = (u32x2){cvt_pk_bf16(fgelu(bf_lo(ua.x)) * (acc[4 * q0] + bb), fgelu(bf_hi(ua.x)) * (acc[4 * q0 + 1] + bb)), cvt_pk_bf16(fgelu(bf_lo(ua.y)) * (acc[4 * q0 + 2] + bb), fgelu(bf_hi(ua.y)) * (acc[4 * q0 + 3] + bb))};
                u32x2 nb = (u32x2){cvt_pk_bf16(fgelu(bf_lo(ub.x)) * (acc[4 * q1] + bb), fgelu(bf_hi(ub.x)) * (acc[4 * q1 + 1] + bb)), cvt_pk_bf16(fgelu(bf_lo(ub.y)) * (acc[4 * q1 + 2] + bb), fgelu(bf_hi(ub.y)) * (acc[4 * q1 + 3] + bb))};
                { auto t2 = __builtin_amdgcn_permlane32_swap(na.x, nb.x, false, false); na.x = t2[0]; nb.x = t2[1]; }
                { auto t2 = __builtin_amdgcn_permlane32_swap(na.y, nb.y, false, false); na.y = t2[0]; nb.y = t2[1]; }
                *(u32x4*)(urow + 16 * kk) = (u32x4){na.x, na.y, nb.x, nb.y};
            }
        }
        if (un < NCHUNK * 8) { float a = (spre[0] + spre[1]) + (spre[2] + spre[3]); a += shx(a, 1, F.lane); a += shx(a, 2, F.lane); if ((F.tid & 3) == 0) rrn[F.tid >> 2] = rsqrtf(a * (1.0f / DM) + EPS); }
        u = un;
    }
}
constexpr int CH_XS = 0, CH_XW = 17408, CH_BT = 34816, CH_C = 69632, CH_H = 104448  , CH_SC = 139264  , CH_EA = 147456  ;
constexpr int SC_PF = 0, SC_QB = 128, SC_DTF = 256, SC_DTB = 384, SC_WGT = 512, SC_EROW = 640, SC_ESF = 768, SC_ESB = 896;
__device__ __forceinline__ float lane_read(float v, int src_lane) { return __int_as_float(__builtin_amdgcn_ds_bpermute(src_lane << 2, __float_as_int(v))); }
__device__ __forceinline__ float wave_scan_incl(float v, int lane) {
    (void)lane;
#define CH_DPP_ADD(ctrl, rmask, bc) v += __int_as_float(__builtin_amdgcn_update_dpp(0, __float_as_int(v), (ctrl), (rmask), 0xF, (bc)))
    CH_DPP_ADD(0x111, 0xF, true); CH_DPP_ADD(0x112, 0xF, true); CH_DPP_ADD(0x114, 0xF, true); CH_DPP_ADD(0x118, 0xF, true);
    CH_DPP_ADD(0x142, 0xA, false);
    CH_DPP_ADD(0x143, 0xC, false);
#undef CH_DPP_ADD
    return v;
}
__device__ __forceinline__ void chain_scalars(LAS float* sc, LAS float* ea, int lane, float d0, float d1, float A, bool fwd, bool state_dir) {
    const float a0 = d0 * A, a1 = d1 * A;
    const float s0 = wave_scan_incl(a0, lane); const float tot0 = __int_as_float(__builtin_amdgcn_readlane(__float_as_int(s0), 63));
    const float s1 = wave_scan_incl(a1, lane) + tot0; const float atot = __int_as_float(__builtin_amdgcn_readlane(__float_as_int(s1), 63));
    if (fwd) {
        sc[SC_PF + lane] = s0; sc[SC_PF + 64 + lane] = s1; sc[SC_DTF + lane] = d0; sc[SC_DTF + 64 + lane] = d1;
        const float e0 = lane_read(s0, lane | 15), e1 = lane_read(s1, lane | 15);
        sc[SC_ESF + lane] = __expf(e0 - s0) * d0; sc[SC_ESF + 64 + lane] = __expf(e1 - s1) * d1;
        if (state_dir) { sc[SC_WGT + lane] = __expf(atot - s0) * d0; sc[SC_WGT + 64 + lane] = __expf(atot - s1) * d1; sc[SC_EROW + lane] = __expf(s0); sc[SC_EROW + 64 + lane] = __expf(s1); if (lane == 0) ea[0] = __expf(atot); }
    } else {
        const float q0 = s0 - a0, q1 = s1 - a1;
        sc[SC_QB + lane] = q0; sc[SC_QB + 64 + lane] = q1; sc[SC_DTB + lane] = d0; sc[SC_DTB + 64 + lane] = d1;
        const float b0 = lane_read(q0, lane & ~15), b1 = lane_read(q1, lane & ~15);
        sc[SC_ESB + lane] = __expf(q0 - b0) * d0; sc[SC_ESB + 64 + lane] = __expf(q1 - b1) * d1;
        if (state_dir) { sc[SC_WGT + lane] = __expf(q0) * d0; sc[SC_WGT + 64 + lane] = __expf(q1) * d1; sc[SC_EROW + lane] = __expf(atot - q0); sc[SC_EROW + 64 + lane] = __expf(atot - q1); if (lane == 0) ea[0] = __expf(atot); }
    }
}
template <int pass>
__device__ __forceinline__ void chain_write_tiles(LAS unsigned char* L, int tid, const LAS float* sc, const u32x4 (&xv)[2], const u32x4 (&bv)[4], const u32x4 (&cv)[4]) {
#pragma unroll
    for (int k = 0; k < 2; ++k) { const int id = tid + 512 * k, pp = id >> 4, q = id & 15;
        if (pass) *(LAS u32x4*)(L + CH_XS + pp * PITCH + q * 16) = xv[k];
        const f32x4 w0 = *(const LAS f32x4*)(sc + SC_WGT + q * 8), w1 = *(const LAS f32x4*)(sc + SC_WGT + q * 8 + 4);
        u32x4 o; o.x = cvt_pk_bf16(bf_lo(xv[k].x) * w0[0], bf_hi(xv[k].x) * w0[1]); o.y = cvt_pk_bf16(bf_lo(xv[k].y) * w0[2], bf_hi(xv[k].y) * w0[3]);
        o.z = cvt_pk_bf16(bf_lo(xv[k].z) * w1[0], bf_hi(xv[k].z) * w1[1]); o.w = cvt_pk_bf16(bf_lo(xv[k].w) * w1[2], bf_hi(xv[k].w) * w1[3]);
        *(LAS u32x4*)(L + CH_XW + pp * PITCH + q * 16) = o; }
#pragma unroll
    for (int k = 0; k < 4; ++k) { const int id = tid + 512 * k, rw = id >> 4, q = id & 15;
        *(LAS u32x4*)(L + CH_BT + rw * PITCH + q * 16) = bv[k]; *(LAS u32x4*)(L + CH_C + rw * PITCH + q * 16) = cv[k]; }
}
#define CH_LDS_BARRIER() asm volatile("s_waitcnt lgkmcnt(0)\n\ts_barrier" ::: "memory")
template <int pass>
__device__ __forceinline__ void chain_pass(const Params& p, const Ctx& F, int layer, int unit) {
    const int b = unit >> 5, h = unit & 31, g = h >> 3;
    const bf16_t* XT = (const bf16_t*)(p.ws + D_XT); const bf16_t* BT = (const bf16_t*)(p.ws + D_BT); const bf16_t* CM = (const bf16_t*)(p.ws + D_CM); const bf16_t* CB = (const bf16_t*)(p.ws + D_CB);
    const float* DT = (const float*)(p.ws + WS_DT); bf16_t* Y = (bf16_t*)(p.ws + D_Y);
    LAS unsigned char* L = F.lds;
    const float Af = -__expf(p.a_log[layer * 64 + h]), Ab = -__expf(p.a_log[layer * 64 + 32 + h]), Dsk = p.d_skip[layer * 32 + h];
    const int pj = F.wave & 1, li = F.wave >> 1;
    const int dcol = pass ? ((F.wave & 1) ? 32 + h : h) : 32 + h;
#define CH_LANE_VARS int tid_ = F.tid; asm volatile("" : "+v"(tid_)); const int lane_ = tid_ & 63, r = lane_ & 31, hh = lane_ >> 5, lcol = li * 32 + r; const size_t yoff = (size_t)lcol * DSSD + h * HDIM + pj * 32 + 8 * hh  , sto = (size_t)(tid_ >> 4) * DSSD + h * HDIM + (tid_ & 15) * 4  ; (void)yoff; (void)sto; (void)r; (void)hh;
    f32x16 hst;
    __syncthreads();
    for (int i = F.tid; i < 64 * PITCH / 16; i += 512) *(LAS u32x4*)(L + CH_H + i * 16) = (u32x4){0u, 0u, 0u, 0u};
#pragma unroll
    for (int i = 0; i < 16; ++i) hst[i] = 0.f;
    u32x4 xv[2], bv[4], cv[4], cbv[8]; u32x2 stv[4]; float nd0, nd1;
#define CH_CIDX(s) (pass ? (s) : ((s) < 2 ? 1 - (s) : 35 - (s)))
#define CH_ISSUE_CB(ca) do { \
        if (pass) { const bf16_t* cbrow = CB + (size_t)((ca) * NGRP + g) * CHK * CHK + ((size_t)li * 512 + lane_) * 8; const bf16_t* yr = Y + (size_t)(ca) * CHK * DSSD + sto; \
            _Pragma("unroll") for (int j = 0; j < 8; ++j) cbv[j] = *(const u32x4*)(cbrow + j * 512); \
            _Pragma("unroll") for (int q = 0; q < 4; ++q) stv[q] = *(const u32x2*)(yr + (size_t)q * 32 * DSSD); } } while (0)
    {
        CH_LANE_VARS
        const int cc = b * NCB + CH_CIDX(0);
        LAS float* sc = (LAS float*)(L + CH_SC); LAS float* ea = (LAS float*)(L + CH_EA);
        { const u32x4* xs = (const u32x4*)(XT + (size_t)(cc * NH + h) * HDIM * CHK); const u32x4* bs = (const u32x4*)(BT + (size_t)(cc * NGRP + g) * CHK * NST); const u32x4* cs = (const u32x4*)(CM + (size_t)(cc * NGRP + g) * CHK * NST);
#pragma unroll
          for (int k = 0; k < 2; ++k) xv[k] = xs[tid_ + 512 * k];
#pragma unroll
          for (int k = 0; k < 4; ++k) { bv[k] = bs[tid_ + 512 * k]; cv[k] = cs[tid_ + 512 * k]; } }
        nd0 = DT[(size_t)(cc * CHK + lane_) * 64 + dcol]; nd1 = DT[(size_t)(cc * CHK + 64 + lane_) * 64 + dcol];
        if (F.wave == 0) chain_scalars(sc, ea, lane_, nd0, nd1, pass ? Af : Ab, pass != 0, true);
        else if (F.wave == 1 && pass) chain_scalars(sc, ea, lane_, nd0, nd1, Ab, false, false);
        __syncthreads();
        chain_write_tiles<pass>(L, tid_, sc, xv, bv, cv);
        CH_ISSUE_CB(cc);
    }
#pragma unroll 1
    for (int step = 0;; ++step) {
        CH_LANE_VARS
        const int cc = b * NCB + CH_CIDX(step), row0 = cc * CHK;
        const int sn = step + 1;
        LAS float* sc = (LAS float*)(L + CH_SC + (step & 1) * 4096); LAS float* scn = (LAS float*)(L + CH_SC + (sn & 1) * 4096);
        LAS float* ea = (LAS float*)(L + CH_EA + (step & 1) * 16); LAS float* ean = (LAS float*)(L + CH_EA + (sn & 1) * 16);
        LAS unsigned char* hB = L + CH_H + (step & 1) * 17408; LAS unsigned char* hBn = L + CH_H + (sn & 1) * 17408;
        CH_LDS_BARRIER();
        const int s1c = sn < NCB ? sn : NCB - 1; const int ccn = b * NCB + CH_CIDX(s1c);
        const u32x4* xs = (const u32x4*)(XT + (size_t)(ccn * NH + h) * HDIM * CHK) + tid_; const u32x4* bs = (const u32x4*)(BT + (size_t)(ccn * NGRP + g) * CHK * NST) + tid_; const u32x4* cs = (const u32x4*)(CM + (size_t)(ccn * NGRP + g) * CHK * NST) + tid_;
        f32x16 yo, yd;
#pragma unroll
        for (int i = 0; i < 16; ++i) yo[i] = 0.f;
        {
            bf16x8 a = *(const LAS bf16x8*)(hB + (pj * 32 + r) * PITCH + hh * 16), bb = *(const LAS bf16x8*)(L + CH_C + lcol * PITCH + hh * 16);
#pragma unroll
            for (int ks = 0; ks < 8; ++ks) {
                bf16x8 an = a, bn = bb;
                if (ks < 7) { an = *(const LAS bf16x8*)(hB + (pj * 32 + r) * PITCH + (ks + 1) * 32 + hh * 16); bn = *(const LAS bf16x8*)(L + CH_C + lcol * PITCH + (ks + 1) * 32 + hh * 16); }
                else { an = *(const LAS bf16x8*)(L + CH_BT + (li * 32 + r) * PITCH + hh * 16); bn = *(const LAS bf16x8*)(L + CH_XW + (pj * 32 + r) * PITCH + hh * 16); }
                yo = MFMA32(a, bb, yo);
                if (ks == 0) nd0 = DT[(size_t)(ccn * CHK + lane_) * 64 + dcol]; else if (ks == 1) nd1 = DT[(size_t)(ccn * CHK + 64 + lane_) * 64 + dcol]; else if (ks < 4) xv[ks - 2] = xs[512 * (ks - 2)]; else bv[ks - 4] = bs[512 * (ks - 4)];
                __builtin_amdgcn_sched_barrier(0);
                a = an; bb = bn;
            }
            { const float eav = ea[0];
#pragma unroll
              for (int i = 0; i < 16; ++i) hst[i] *= eav; }
#pragma unroll
            for (int ks = 0; ks < 8; ++ks) {
                bf16x8 an = a, bn = bb;
                if (ks < 7) { an = *(const LAS bf16x8*)(L + CH_BT + (li * 32 + r) * PITCH + (ks + 1) * 32 + hh * 16); bn = *(const LAS bf16x8*)(L + CH_XW + (pj * 32 + r) * PITCH + (ks + 1) * 32 + hh * 16); }
                hst = MFMA32(a, bb, hst);
                if (ks < 4) cv[ks] = cs[512 * ks];
                __builtin_amdgcn_sched_barrier(0);
                a = an; bb = bn;
            }
        }
#pragma unroll
        for (int q = 0; q < 4; ++q)
            *(LAS u32x2*)(hBn + (pj * 32 + r) * PITCH + (li * 32 + 8 * q + 4 * hh) * 2) = (u32x2){cvt_pk_bf16(hst[4 * q], hst[4 * q + 1]), cvt_pk_bf16(hst[4 * q + 2], hst[4 * q + 3])};
        { const float er = sc[SC_EROW + lcol];
#pragma unroll
          for (int q = 0; q < 4; ++q) {
              yd[4 * q] = er * yo[4 * q]; yd[4 * q + 1] = er * yo[4 * q + 1]; yd[4 * q + 2] = er * yo[4 * q + 2]; yd[4 * q + 3] = er * yo[4 * q + 3];
              if (pass) { yd[4 * q] += bf_lo(stv[q].x); yd[4 * q + 1] += bf_hi(stv[q].x); yd[4 * q + 2] += bf_lo(stv[q].y); yd[4 * q + 3] += bf_hi(stv[q].y); }
          } }
        if (pass) {
            const bf16_t* cbrow_n = CB + (size_t)(ccn * NGRP + g) * CHK * CHK + ((size_t)li * 512 + lane_) * 8  ; const bf16_t* yr_n = Y + (size_t)ccn * CHK * DSSD + sto;
            int lcl = lcol; asm volatile("" : "+v"(lcl));
            const float pfl = sc[SC_PF + lcol], qbl = sc[SC_QB + lcol], dtbl = sc[SC_DTB + lcol];
#pragma unroll
            for (int j = 0; j < 8; ++j) {
                const int ks = (2 * li + j) & 7, s0 = ks * 16 + hh * 8;
                const float cbf[8] = {bf_lo(cbv[j].x), bf_hi(cbv[j].x), bf_lo(cbv[j].y), bf_hi(cbv[j].y), bf_lo(cbv[j].z), bf_hi(cbv[j].z), bf_lo(cbv[j].w), bf_hi(cbv[j].w)};
                float mv[8];
                if (j < 2) {
                    const f32x4 pf0 = *(const LAS f32x4*)(sc + SC_PF + s0), pf1 = *(const LAS f32x4*)(sc + SC_PF + s0 + 4), qb0 = *(const LAS f32x4*)(sc + SC_QB + s0), qb1 = *(const LAS f32x4*)(sc + SC_QB + s0 + 4);
                    const f32x4 df0 = *(const LAS f32x4*)(sc + SC_DTF + s0), df1 = *(const LAS f32x4*)(sc + SC_DTF + s0 + 4), db0 = *(const LAS f32x4*)(sc + SC_DTB + s0), db1 = *(const LAS f32x4*)(sc + SC_DTB + s0 + 4);
#pragma unroll
                    for (int e = 0; e < 8; ++e) {
                        const int sp = s0 + e; const float pfs = e < 4 ? pf0[e] : pf1[e - 4], qbs = e < 4 ? qb0[e] : qb1[e - 4], dfs = e < 4 ? df0[e] : df1[e - 4], dbs = e < 4 ? db0[e] : db1[e - 4];
                        const float arg = (sp <= lcl) ? (pfl - pfs) : (qbs - qbl);
                        float m = cbf[e] * __expf(arg) * ((sp <= lcl) ? dfs : dbs);
                        if (sp == lcl) m += cbf[e] * dtbl + Dsk;
                        mv[e] = m;
                    }
                } else {
                    const bool fwd = ks < 2 * li;
                    const float x = sc[fwd ? SC_PF + ks * 16 + 15 : SC_QB + ks * 16];
                    const float el = __expf(fwd ? pfl - x : x - qbl);
                    const LAS float* es = sc + (fwd ? SC_ESF : SC_ESB) + s0;
                    const f32x4 e0 = *(const LAS f32x4*)es, e1 = *(const LAS f32x4*)(es + 4);
#pragma unroll
                    for (int e = 0; e < 8; ++e) mv[e] = cbf[e] * (el * (e < 4 ? e0[e] : e1[e - 4]));
                }
                bf16x8 mb; { u32x4 t; t.x = cvt_pk_bf16(mv[0], mv[1]); t.y = cvt_pk_bf16(mv[2], mv[3]); t.z = cvt_pk_bf16(mv[4], mv[5]); t.w = cvt_pk_bf16(mv[6], mv[7]); mb = *(bf16x8*)&t; }
                const bf16x8 a = *(const LAS bf16x8*)(L + CH_XS + (pj * 32 + r) * PITCH + ks * 32 + hh * 16);
                yd = MFMA32(a, mb, yd);
                cbv[j] = *(const u32x4*)(cbrow_n + j * 512);
                if (j < 4) stv[j] = *(const u32x2*)(yr_n + (size_t)j * 32 * DSSD);
            }
        }
        u32x4 ow[2];
        {
            u32x2 o[4];
#pragma unroll
            for (int q = 0; q < 4; ++q) o[q] = (u32x2){cvt_pk_bf16(yd[4 * q], yd[4 * q + 1]), cvt_pk_bf16(yd[4 * q + 2], yd[4 * q + 3])};
            if (!pass) {
                bf16_t* ys = Y + (size_t)row0 * DSSD + sto;
#pragma unroll
                for (int q = 0; q < 4; ++q) *(u32x2*)(ys + (size_t)q * 32 * DSSD) = o[q];
            } else {
#pragma unroll
                for (int kk = 0; kk < 2; ++kk) {
                    u32x2 a = o[2 * kk], bq = o[2 * kk + 1];
                    { auto t = __builtin_amdgcn_permlane32_swap(a.x, bq.x, false, false); a.x = t[0]; bq.x = t[1]; }
                    { auto t = __builtin_amdgcn_permlane32_swap(a.y, bq.y, false, false); a.y = t[0]; bq.y = t[1]; }
                    ow[kk] = (u32x4){a.x, a.y, bq.x, bq.y};
                }
            }
        }
        if (step == NCB - 1) {
            if (pass) { CH_LDS_BARRIER(); bf16_t* yrow = Y + (size_t)row0 * DSSD + yoff; *(u32x4*)yrow = ow[0]; *(u32x4*)(yrow + 16) = ow[1]; }
            break;
        }
        if (F.wave == 0) chain_scalars(scn, ean, lane_, nd0, nd1, pass ? Af : Ab, pass != 0, true);
        else if (F.wave == 1 && pass) chain_scalars(scn, ean, lane_, nd0, nd1, Ab, false, false);
        CH_LDS_BARRIER();
        if (pass) { bf16_t* yrow = Y + (size_t)row0 * DSSD + yoff; *(u32x4*)yrow = ow[0]; *(u32x4*)(yrow + 16) = ow[1]; }
        chain_write_tiles<pass>(L, tid_, scn, xv, bv, cv);
    }
#undef CH_ISSUE_CB
#undef CH_LANE_VARS
#undef CH_CIDX
    asm volatile("s_waitcnt vmcnt(0)" ::: "memory");
    __syncthreads();
    __builtin_amdgcn_fence(__ATOMIC_ACQUIRE, "agent");
}
__device__ __forceinline__ void chain_unit(const Params& p, const Ctx& F, int layer, int unit) { chain_pass<0>(p, F, layer, unit); chain_pass<1>(p, F, layer, unit); }
__device__ __forceinline__ void phase_chain(const Params& p, const Ctx& F, int layer) {
    for (int u = F.bid; u < NB * NH; u += F.G) {
        int unit = u;
        if (F.G == 256) { const int x = u & 7, j = u >> 3, pi = x * 4 + (j >> 3); unit = (pi >> 2) * 32 + (pi & 3) * 8 + (j & 7); }
        chain_unit(p, F, layer, unit);
    }
}
constexpr size_t CNTB_TILEE = 16384, CNTB_NT = 20480;
__device__ __forceinline__ void phase_moe_route(const Params& p, const Ctx& F) {
    const int layer = 1;
    bf16_t* H2 = (bf16_t*)(p.ws + D_H2M); int* TOKE = (int*)(p.ws + WS_TOKE); float* TOKP = (float*)(p.ws + WS_TOKP); int* CNTB = (int*)(p.ws + WS_CNTB);
    LAS int* cnt = (LAS int*)F.lds;
    const float* g = p.norm2_g + layer * DM;
    for (int blk = F.bid; blk < NB * SEQ / 128; blk += F.G) {
        __syncthreads();
        if (F.tid < 8) cnt[F.tid] = 0;
        { const int b0 = (blk * 128) / SEQ; const float* sh0 = (const float*)(p.ws + WS_MOD) + ((size_t)(layer * 9 + b0) * 6 + 3) * DM; const float* sc0 = sh0 + DM;
          LAS float* mA = (LAS float*)(F.lds + 1024); LAS float* mB = mA + DM;
#pragma unroll
          for (int k = 0; k < 2; ++k) { const int i = F.tid + 512 * k; mA[i] = g[i] * (sc0[i] + 1.0f); mB[i] = sh0[i]; } }
        __syncthreads();
        f32x4 wr[4][4][2];
#pragma unroll
        for (int q = 0; q < 4; ++q)
#pragma unroll
            for (int j = 0; j < 4; ++j) { const float* wp = p.moe_router_w + (size_t)(q * 256 + F.lane * 4 + j) * NE; wr[q][j][0] = *(const f32x4*)wp; wr[q][j][1] = *(const f32x4*)(wp + 4); }
        const f32x4 rb0 = *(const f32x4*)p.moe_router_b, rb1 = *(const f32x4*)(p.moe_router_b + 4);
        f32x4 vn[4];
        { const float* xr0 = p.out + (size_t)(blk * 128 + F.wave * 16) * DM;
#pragma unroll
          for (int q = 0; q < 4; ++q) vn[q] = *(const f32x4*)(xr0 + q * 256 + F.lane * 4); }
#pragma unroll 1
        for (int i = 0; i < 16; ++i) {
            const int t = blk * 128 + F.wave * 16 + i, b = t / SEQ;
            (void)b;
            f32x4 v[4]; float ss = 0.f;
#pragma unroll
            for (int q = 0; q < 4; ++q) { v[q] = vn[q]; ss += v[q][0] * v[q][0] + v[q][1] * v[q][1] + v[q][2] * v[q][2] + v[q][3] * v[q][3]; }
            { const float* xrn = p.out + (size_t)(t + (i < 15 ? 1 : 0)) * DM;
#pragma unroll
              for (int q = 0; q < 4; ++q) vn[q] = *(const f32x4*)(xrn + q * 256 + F.lane * 4); }
            ss = wave_sum(ss, F.lane);
            const float rs = rsqrtf(ss * (1.0f / DM) + EPS);
            f32x4 l0 = (f32x4){0.f, 0.f, 0.f, 0.f}, l1 = l0; float am = 0.f;
#pragma unroll
            for (int q = 0; q < 4; ++q) {
                const int col = q * 256 + F.lane * 4;
                const f32x4 ma = *(const LAS f32x4*)((LAS float*)(F.lds + 1024) + col), mb = *(const LAS f32x4*)((LAS float*)(F.lds + 1024) + DM + col);
                const f32x4 o = v[q] * rs * ma + mb; v[q] = o;
                am = __builtin_fmaxf(am, __builtin_fmaxf(__builtin_fmaxf(__builtin_fabsf(o[0]), __builtin_fabsf(o[1])), __builtin_fmaxf(__builtin_fabsf(o[2]), __builtin_fabsf(o[3]))));
#pragma unroll
                for (int j = 0; j < 4; ++j) { l0 += wr[q][j][0] * o[j]; l1 += wr[q][j][1] * o[j]; }
            }
            float inv = 0.f;
            if (UP_MODE == 2) { am = wave_max(am, F.lane); const float scl = am > 0.f ? am * (1.0f / 127.f) : 1.0f; inv = 1.0f / scl; if (F.lane == 0) ((float*)(p.ws + WS_SA))[t] = scl; }
#pragma unroll
            for (int q = 0; q < 4; ++q) {
                const int col = q * 256 + F.lane * 4; const f32x4 o = v[q];
                if (UP_MODE == 2) *(unsigned*)((unsigned char*)H2 + (size_t)t * DM + col) = pack_i8x4(o[0], o[1], o[2], o[3], inv);
                else if (UP_MODE == 1) *(unsigned*)((unsigned char*)H2 + (size_t)t * DM + col) = cvt_pk4_fp8(o[0], o[1], o[2], o[3]);
                else *(u32x2*)(H2 + (size_t)t * DM + col) = (u32x2){cvt_pk_bf16(o[0], o[1]), cvt_pk_bf16(o[2], o[3])};
            }
            float lg[8];
#pragma unroll
            for (int e = 0; e < 4; ++e) { lg[e] = wave_sum(l0[e], F.lane) + rb0[e]; lg[4 + e] = wave_sum(l1[e], F.lane) + rb1[e]; }
            int i0 = 0; float v0 = lg[0];
#pragma unroll
            for (int e = 1; e < 8; ++e) if (lg[e] > v0) { v0 = lg[e]; i0 = e; }
            int i1 = -1; float v1 = -3.0e38f;
#pragma unroll
            for (int e = 0; e < 8; ++e) if (e != i0 && lg[e] > v1) { v1 = lg[e]; i1 = e; }
            const float p0 = 1.0f / (1.0f + __expf(v1 - v0));
            if (F.lane == 0) { TOKE[t * 2] = i0; TOKE[t * 2 + 1] = i1; TOKP[t * 2] = p0; TOKP[t * 2 + 1] = 1.0f - p0; atomicAdd((int*)&cnt[i0], 1); atomicAdd((int*)&cnt[i1], 1); }
        }
        __syncthreads();
        if (F.tid < 8) CNTB[blk * 8 + F.tid] = cnt[F.tid];
    }
}
__device__ __forceinline__ void phase_moe_sort(const Params& p, const Ctx& F) {
    const bf16_t* H2 = (const bf16_t*)(p.ws + D_H2M); bf16_t* H2S = (bf16_t*)(p.ws + D_H2S);
    const int* TOKE = (const int*)(p.ws + WS_TOKE); int* TOKS = (int*)(p.ws + WS_TOKS); const int* CNTB = (const int*)(p.ws + WS_CNTB);
    int* TILEE = (int*)(p.ws + WS_CNTB + CNTB_TILEE); int* NT = (int*)(p.ws + WS_CNTB + CNTB_NT);
    LAS int* tot = (LAS int*)F.lds; LAS int* pre = tot + 8; LAS int* off = tot + 16; LAS int* wt = tot + 32; LAS int* slots = tot + 64;
    for (int blk = F.bid; blk < NB * SEQ / 128; blk += F.G) {
        __syncthreads();
        if (F.tid < 64) tot[F.tid] = 0;
        __syncthreads();
        if (F.tid < 256) {
#pragma unroll
            for (int e = 0; e < 8; ++e) { const int cv = CNTB[F.tid * 8 + e]; atomicAdd((int*)&tot[e], cv); if (F.tid < blk) atomicAdd((int*)&pre[e], cv); }
        }
        __syncthreads();
        if (F.tid == 0) { int o = 0; for (int e = 0; e < 8; ++e) { off[e] = o; o += (tot[e] + 255) & ~255; } off[8] = o; }
        __syncthreads();
        if (blk == 0 && F.tid < MOE_MAXT) { const int r0 = F.tid * 256; int e = 7; for (int k = 7; k >= 0; --k) if (r0 < off[k + 1]) e = k; TILEE[F.tid] = e; if (F.tid == 0) NT[0] = off[8] >> 8; }
        int e0 = 0, e1 = 0, rk0 = 0, rk1 = 0;
        if (F.tid < 128) {
            const int t = blk * 128 + F.tid; e0 = TOKE[t * 2]; e1 = TOKE[t * 2 + 1];
            const unsigned long long lt = (F.lane == 0) ? 0ull : (~0ull >> (64 - F.lane));
#pragma unroll
            for (int e = 0; e < 8; ++e) {
                const unsigned long long m = __ballot(e0 == e || e1 == e);
                const int rk = __popcll(m & lt);
                if (e0 == e) rk0 = rk; if (e1 == e) rk1 = rk;
                if (F.lane == 0) wt[F.wave * 8 + e] = __popcll(m);
            }
        }
        __syncthreads();
        if (F.tid < 128) {
            const int t = blk * 128 + F.tid;
            const int s0 = off[e0] + pre[e0] + rk0 + (F.wave ? wt[e0] : 0), s1 = off[e1] + pre[e1] + rk1 + (F.wave ? wt[e1] : 0);
            TOKS[t * 2] = s0; TOKS[t * 2 + 1] = s1; slots[F.tid * 2] = s0; slots[F.tid * 2 + 1] = s1;
            if (UP_MODE == 2) { const float sa = ((const float*)(p.ws + WS_SA))[t]; ((float*)(p.ws + WS_SA2))[s0] = sa; ((float*)(p.ws + WS_SA2))[s1] = sa; }
        }
        __syncthreads();
        constexpr int RC = DM * UPESZ / 16;
        static_assert((256 * RC) % (512 * 8) == 0, "copy batches");
#pragma unroll 1
        for (int base = F.tid; base < 256 * RC; base += 512 * 8) {
            u32x4 tmp[8];
#pragma unroll
            for (int k = 0; k < 8; ++k) { const int id = base + 512 * k, pr = id / RC, q = id % RC; tmp[k] = *(const u32x4*)((const unsigned char*)H2 + ((size_t)(blk * 128 + (pr >> 1)) * DM * UPESZ + q * 16)); }
#pragma unroll
            for (int k = 0; k < 8; ++k) { const int id = base + 512 * k, pr = id / RC, q = id % RC; *(u32x4*)((unsigned char*)H2S + ((size_t)slots[pr] * DM * UPESZ + q * 16)) = tmp[k]; }
        }
    }
}
__device__ __forceinline__ void phase_final(const Params& p, const Ctx& F) {
    const bf16_t* O = (const bf16_t*)(p.ws + D_O); const int* TOKS = (const int*)(p.ws + WS_TOKS); const float* TOKP = (const float*)(p.ws + WS_TOKP);
    f32x4 gf[4];
#pragma unroll
    for (int q = 0; q < 4; ++q) gf[q] = *(const f32x4*)(p.final_norm_g + q * 256 + F.lane * 4);
    for (int pr = F.bid * 8 + F.wave; 2 * pr < NB * SEQ; pr += F.G * 8) {
        const int t0 = 2 * pr, b = t0 / SEQ; float* xr = p.out + (size_t)t0 * DM;
        const float* gate = (const float*)(p.ws + WS_MOD) + ((size_t)(1 * 9 + b) * 6 + 5) * DM;
        const u32x4 sl = *(const u32x4*)(TOKS + t0 * 2); const f32x4 pp = *(const f32x4*)(TOKP + t0 * 2);
        f32x4 v[2][4]; float ss[2] = {0.f, 0.f};
#pragma unroll
        for (int e = 0; e < 2; ++e) { const int s0 = e ? (int)sl.z : (int)sl.x, s1 = e ? (int)sl.w : (int)sl.y; const float p0 = e ? pp[2] : pp[0], p1 = e ? pp[3] : pp[1];
#pragma unroll
            for (int q = 0; q < 4; ++q) {
                const int col = q * 256 + F.lane * 4;
                const u32x2 a = *(const u32x2*)(O + (size_t)s0 * DM + col), c = *(const u32x2*)(O + (size_t)s1 * DM + col);
                const f32x4 gg = *(const f32x4*)(gate + col); f32x4 x = *(const f32x4*)(xr + e * DM + col);
                x[0] += gg[0] * (p0 * bf_lo(a.x) + p1 * bf_lo(c.x)); x[1] += gg[1] * (p0 * bf_hi(a.x) + p1 * bf_hi(c.x));
                x[2] += gg[2] * (p0 * bf_lo(a.y) + p1 * bf_lo(c.y)); x[3] += gg[3] * (p0 * bf_hi(a.y) + p1 * bf_hi(c.y));
                v[e][q] = x; ss[e] += x[0] * x[0] + x[1] * x[1] + x[2] * x[2] + x[3] * x[3];
            } }
        { ss[0] = wave_sum(ss[0], F.lane); ss[1] = wave_sum(ss[1], F.lane); }
#pragma unroll
        for (int e = 0; e < 2; ++e) { const float rs = rsqrtf(ss[e] * (1.0f / DM) + EPS);
#pragma unroll
            for (int q = 0; q < 4; ++q) *(f32x4*)(xr + e * DM + q * 256 + F.lane * 4) = v[e][q] * rs * gf[q]; }
    }
}
constexpr int NPH = 27;
#ifndef DBG_NPH
#define DBG_NPH NPH
#endif
__device__ __forceinline__ pg8::Sched make_sched(const Ctx& F, int nM, int nN, bool lat_only) {
    pg8::Sched S{}; S.nM = nM; S.nN = nN; S.G = F.G; S.c = F.bid; S.nseg = 1; S.lat_only = lat_only ? 1 : 0; S.tm0 = 0; S.tileE = nullptr; S.bstrideE = 0;
    S.A0 = S.A1 = S.B0 = S.B1 = nullptr; S.lda0 = S.lda1 = S.K0 = S.K1 = 0; return S;
}
typedef const __attribute__((address_space(4))) Params* KP4;
__device__ __forceinline__ const Params& fresh_params() { KP4 q = (KP4)__builtin_amdgcn_kernarg_segment_ptr(); asm volatile("" : "+s"(q)); return *(const Params*)q; }
__device__ __forceinline__ Ctx fresh_ctx(LAS unsigned char* lds, int wave_s) { Ctx F; unsigned m_ = ~0u; asm volatile("" : "+s"(m_)); int t = wave_s * 64 + (int)__builtin_amdgcn_mbcnt_hi(m_, __builtin_amdgcn_mbcnt_lo(m_, 0u)); asm volatile("" : "+v"(t)); unsigned l32 = (unsigned)(unsigned long long)lds; int g = gridDim.x, b = blockIdx.x; asm volatile("" : "+s"(l32), "+s"(g), "+s"(b));
    F.lds = (LAS unsigned char*)(unsigned long long)l32; F.tid = t; F.lane = t & 63; F.wave = __builtin_amdgcn_readfirstlane(t >> 6); F.G = g; F.bid = b; return F; }
__global__ void __launch_bounds__(512, 2) hybrid_fwd(Params p_arg) {
    extern __shared__ __attribute__((aligned(16))) unsigned char lds_raw[];
    LAS unsigned char* const lds0 = (LAS unsigned char*)lds_raw;
    volatile LAS unsigned* misc = (volatile LAS unsigned*)(lds0 + LDS_MISC);
    const int wave_s = __builtin_amdgcn_readfirstlane(threadIdx.x >> 6);
    if (threadIdx.x < 64) misc[threadIdx.x] = 0u;
    __syncthreads();
    XcdBarrier bar; bar.bar = (unsigned*)(p_arg.ws + WS_CTL); bar.x = 0; bar.st = nullptr;
#if !MK_PER_PHASE
    bar = xcd_barrier_post((unsigned*)(p_arg.ws + WS_CTL), misc + 8);
#endif
    const int lo = p_arg.ph_lo, hi = p_arg.ph_hi;
#define IN(k) (lo <= (k) && (k) < hi)
#define DEFER(F) ((F).G == 256 && lo == 0 && hi == NPH)
#if MK_PER_PHASE
#define SEAM(k) do { } while (0)
#else
#define SEAM(k) do { if (IN((k) + 1)) xcd_barrier(bar); } while (0)
#endif
    if (IN(0)) { const Params& p = fresh_params(); const Ctx F = fresh_ctx(lds0, wave_s); phase_prologue(p, F, !DEFER(F)); SEAM(0); }
#pragma unroll 1
    for (int l = 0; l < 2; ++l) {
        const int l_ = l;
        const int base = l ? 12 : 1;
        if (IN(base + 0)) { const Params& p = fresh_params(); const Ctx F = fresh_ctx(lds0, wave_s); unsigned char* const ws = p.ws; unsigned char* const wl = ws + WS_WL + (size_t)l_ * WL_STRIDE; (void)wl; phase_norm(p, F, l, l, p.norm1_g + l * DM, 0, (bf16_t*)(ws + D_H), false, IN_MODE, (float*)(ws + WS_SA)); SEAM(base + 0); }
        if (IN(base + 1)) { const Params& p = fresh_params(); const Ctx F = fresh_ctx(lds0, wave_s); unsigned char* const ws = p.ws; unsigned char* const wl = ws + WS_WL + (size_t)l_ * WL_STRIDE; (void)wl;
            pg8::Sched S = make_sched(F, NTILE, NG1 / 256, false); S.A0 = (const char*)(ws + D_H); S.lda0 = DM * INESZ; S.K0 = DM * INESZ; S.B0 = (const char*)(wl + WL_G1);
            EpiG1 E{(bf16_t*)(ws + D_XBC), (float*)(ws + WS_DT), p.dt_bias + l * 64, (const float*)(ws + WS_SA), (const float*)(ws + WS_SW) + l * SW_L};
            pg8::gemm_phase<EpiG1, false, IN_MODE>(F.lds, F.tid, S, E); SEAM(base + 1); }
        if (IN(base + 2)) { const Params& p = fresh_params(); const Ctx F = fresh_ctx(lds0, wave_s); unsigned char* const ws = p.ws; unsigned char* const wl = ws + WS_WL + (size_t)l_ * WL_STRIDE; (void)wl; phase_conv(p, F, l); SEAM(base + 2); }
        if (IN(base + 3)) { const Params& p = fresh_params(); const Ctx F = fresh_ctx(lds0, wave_s); unsigned char* const ws = p.ws; unsigned char* const wl = ws + WS_WL + (size_t)l_ * WL_STRIDE; (void)wl; phase_chain(p, F, l); SEAM(base + 3); }
        if (IN(base + 4)) { const Params& p = fresh_params(); const Ctx F = fresh_ctx(lds0, wave_s); unsigned char* const ws = p.ws; unsigned char* const wl = ws + WS_WL + (size_t)l_ * WL_STRIDE; (void)wl;
            pg8::Sched S = make_sched(F, l ? NLT : NTILE, NG2 / 256, l != 0); S.A0 = (const char*)(ws + D_H); S.lda0 = DM * INESZ; S.K0 = DM * INESZ; S.B0 = (const char*)(wl + WL_G2);
            EpiG2 E{(bf16_t*)(ws + D_Y), (bf16_t*)(ws + D_G), (bf16_t*)(ws + D_U), (bf16_t*)(ws + D_V), (float*)(ws + WS_SSQ1), (float*)(ws + WS_SSQ2), (const float*)(ws + WS_SA), (const float*)(ws + WS_SW) + l * SW_L + NG1};
            pg8::gemm_phase<EpiG2, false, IN_MODE>(F.lds, F.tid, S, E); SEAM(base + 4); }
        if (IN(base + 5)) { const Params& p = fresh_params(); const Ctx F = fresh_ctx(lds0, wave_s); unsigned char* const ws = p.ws; unsigned char* const wl = ws + WS_WL + (size_t)l_ * WL_STRIDE; (void)wl; phase_gmlp(p, F, l, l != 0); SEAM(base + 5); }
        if (IN(base + 6)) { const Params& p = fresh_params(); const Ctx F = fresh_ctx(lds0, wave_s); unsigned char* const ws = p.ws; unsigned char* const wl = ws + WS_WL + (size_t)l_ * WL_STRIDE; (void)wl;
            pg8::Sched S = make_sched(F, l ? NLT : NTILE, DM / 256, l != 0); S.nseg = 2;
            S.A0 = (const char*)(ws + D_Y); S.lda0 = DSSD * 2; S.K0 = DSSD * 2; S.B0 = (const char*)(wl + WL_W1);
            S.A1 = (const char*)(ws + D_U); S.lda1 = DM * 2; S.K1 = DM * 2; S.B1 = (const char*)(wl + WL_W2);
            EpiMerge E{(const bf16_t*)(ws + D_G), (const float*)(ws + WS_SSQ1), (bf16_t*)(ws + D_MG)};
            pg8::gemm_phase<EpiMerge, true>(F.lds, F.tid, S, E);
            if (l == 0 && DEFER(F) && F.bid >= 32) moe_weight_convert(p, F, 0, NE, F.bid - 32, F.G - 32);
            SEAM(base + 6); }
        if (IN(base + 7)) { const Params& p = fresh_params(); const Ctx F = fresh_ctx(lds0, wave_s); unsigned char* const ws = p.ws; unsigned char* const wl = ws + WS_WL + (size_t)l_ * WL_STRIDE; (void)wl;
            pg8::Sched S = make_sched(F, l ? NLT : NTILE, DM / 256, l != 0); S.A0 = (const char*)(ws + D_MG); S.lda0 = DM * 2; S.K0 = DM * 2; S.B0 = (const char*)(wl + WL_WO);
            EpiRes E{l ? (const float*)p.out : p.x, l ? (const float*)(ws + WS_CTXRES) : p.ctx, p.out, (float*)(ws + WS_CTXRES), (const float*)(ws + WS_MOD), l, 2};
            pg8::gemm_phase<EpiRes>(F.lds, F.tid, S, E);
            if (l == 0 && DEFER(F) && F.bid >= 32) convert_jobs(p, F, 9, 18, F.bid - 32, F.G - 32);
            SEAM(base + 7); }
        if (l == 0) {
    if (IN(9)) { const Params& p = fresh_params(); const Ctx F = fresh_ctx(lds0, wave_s); unsigned char* const ws = p.ws; unsigned char* const wl = ws + WS_WL + (size_t)l_ * WL_STRIDE; (void)wl; phase_norm(p, F, 0, 1, p.norm2_g, 3, (bf16_t*)(ws + D_H2), false, UP_MODE, (float*)(ws + WS_SA)); SEAM(9); }
    if (IN(10)) { const Params& p = fresh_params(); const Ctx F = fresh_ctx(lds0, wave_s); unsigned char* const ws = p.ws; unsigned char* const wl = ws + WS_WL + (size_t)l_ * WL_STRIDE; (void)wl;
        pg8::Sched S = make_sched(F, NTILE, 2 * DFF / 256, false); S.A0 = (const char*)(ws + D_H2); S.lda0 = DM * UPESZ; S.K0 = DM * UPESZ; S.B0 = (const char*)(ws + WS_FGU);
        EpiGlu E{(bf16_t*)(ws + D_HD), DFF, 0, (const float*)(ws + WS_SA), (const float*)(ws + WS_SW) + SW_FGU, nullptr, nullptr};
        pg8::gemm_phase<EpiGlu, false, UP_MODE>(F.lds, F.tid, S, E); SEAM(10); }
    if (IN(11)) { const Params& p = fresh_params(); const Ctx F = fresh_ctx(lds0, wave_s); unsigned char* const ws = p.ws; unsigned char* const wl = ws + WS_WL + (size_t)l_ * WL_STRIDE; (void)wl;
        pg8::Sched S = make_sched(F, NTILE, DM / 256, false); S.A0 = (const char*)(ws + D_HD); S.lda0 = DFF * FESZ; S.K0 = DFF * FESZ; S.B0 = (const char*)(ws + WS_FD);
        typedef EpiResT<E8_W, E8_HD> EpiResF; EpiResF E{(const float*)p.out, (const float*)(ws + WS_CTXRES), p.out, (float*)(ws + WS_CTXRES), (const float*)(ws + WS_MOD), 0, 5};
        pg8::gemm_phase<EpiResF, false, DN_MODE>(F.lds, F.tid, S, E);
        SEAM(11); }
        } else {
    if (IN(20)) { const Params& p = fresh_params(); const Ctx F = fresh_ctx(lds0, wave_s); unsigned char* const ws = p.ws; unsigned char* const wl = ws + WS_WL + (size_t)l_ * WL_STRIDE; (void)wl; phase_moe_route(p, F); if (!DEFER(F)) moe_weight_convert(p, F, 0, NE, F.bid, F.G); SEAM(20); }
    if (IN(21)) { const Params& p = fresh_params(); const Ctx F = fresh_ctx(lds0, wave_s); unsigned char* const ws = p.ws; unsigned char* const wl = ws + WS_WL + (size_t)l_ * WL_STRIDE; (void)wl; phase_moe_sort(p, F); SEAM(21); }
#pragma unroll 1
    for (int half = 0; half < 2; ++half) {
        const int ntiles = *(const int*)(fresh_params().ws + WS_CNTB + CNTB_NT);
        const int tm0 = half * MOE_SPLIT; int nM = half ? ntiles - MOE_SPLIT : MOE_SPLIT; nM = nM < 0 ? 0 : (nM > MOE_HALF ? MOE_HALF : nM); if (!half && nM > ntiles) nM = ntiles;
        if (IN(22 + 2 * half)) { const Params& p = fresh_params(); const Ctx F = fresh_ctx(lds0, wave_s); unsigned char* const ws = p.ws; unsigned char* const wl = ws + WS_WL + (size_t)l_ * WL_STRIDE; (void)wl;
            { LAS int* tl = (LAS int*)(F.lds + 131072); if (F.tid < MOE_MAXT) tl[F.tid] = ((const int*)(ws + WS_CNTB + CNTB_TILEE))[F.tid]; __syncthreads(); }
            pg8::Sched S = make_sched(F, nM, 2 * DFFE / 256, false); S.tm0 = tm0; S.tileE = (const int*)(ws + WS_CNTB + CNTB_TILEE); S.bstrideE = WMOE_E; S.tileL = (const LAS int*)(F.lds + 131072);
            S.A0 = (const char*)(ws + D_H2S); S.lda0 = DM * UPESZ; S.K0 = DM * UPESZ; S.B0 = (const char*)(ws + D_WMOE);
            EpiGlu E{(bf16_t*)(ws + D_HDM), DFFE, tm0, (const float*)(ws + WS_SA2), (const float*)(ws + WS_SW) + SW_MOE, (const int*)(ws + WS_CNTB + CNTB_TILEE), (const char*)(ws + D_WMOE)};
            pg8::gemm_phase<EpiGlu, false, UP_MODE>(F.lds, F.tid, S, E); SEAM(22 + 2 * half); }
        if (IN(23 + 2 * half)) { const Params& p = fresh_params(); const Ctx F = fresh_ctx(lds0, wave_s); unsigned char* const ws = p.ws; unsigned char* const wl = ws + WS_WL + (size_t)l_ * WL_STRIDE; (void)wl;
            { LAS int* tl = (LAS int*)(F.lds + 131072); if (F.tid < MOE_MAXT) tl[F.tid] = ((const int*)(ws + WS_CNTB + CNTB_TILEE))[F.tid]; __syncthreads(); }
            pg8::Sched S = make_sched(F, nM, DM / 256, false); S.tm0 = tm0; S.tileE = (const int*)(ws + WS_CNTB + CNTB_TILEE); S.bstrideE = WMOE_E; S.tileL = (const LAS int*)(F.lds + 131072);
            S.A0 = (const char*)(ws + D_HDM) - (size_t)tm0 * 256 * DFFE * FESZ; S.lda0 = DFFE * FESZ; S.K0 = DFFE * FESZ; S.B0 = (const char*)(ws + D_WMOE) + WMOE_UP;
            EpiBf E{(bf16_t*)(ws + D_O), DM};
            pg8::gemm_phase<EpiBf, false, DN_MODE>(F.lds, F.tid, S, E); SEAM(23 + 2 * half); }
    }
    if (IN(26)) { const Params& p = fresh_params(); const Ctx F = fresh_ctx(lds0, wave_s); unsigned char* const ws = p.ws; unsigned char* const wl = ws + WS_WL + (size_t)l_ * WL_STRIDE; (void)wl; phase_final(p, F); }
        }
    }
#undef IN
#undef DEFER
#undef SEAM
}

#ifdef DBG_DUMP_OFF
__global__ void dbg_dump(const unsigned char* ws, float* out) {
    const size_t N = (size_t)NB * SEQ * DM; const size_t E = (size_t)DBG_DUMP_BYTES / (DBG_DUMP_KIND ? 4 : 2);
    for (size_t i = (size_t)blockIdx.x * blockDim.x + threadIdx.x; i < N; i += (size_t)gridDim.x * blockDim.x) {
        float s = 0.f;
        for (size_t k = i; k < E; k += N) s += DBG_DUMP_KIND ? ((const float*)(ws + DBG_DUMP_OFF))[k] : bf2f(((const bf16_t*)(ws + DBG_DUMP_OFF))[k]);
        out[i] = s;
    }
}
#endif
extern "C" void kernel_launch(void* const* d_in, const int* in_sizes, int n_in, void* d_out, int out_size, void* d_ws, size_t ws_size, hipStream_t stream) {
    static int grid = 0;
    if (grid == 0) {
        if (n_in != 30 || in_sizes[0] != NB * SEQ * DM || out_size != NB * SEQ * DM || ws_size < WS_NEED) {
            fprintf(stderr, "kernel_launch: unexpected problem (n_in %d, in0 %d, out %d, ws %zu, need %zu); nothing launched\n", n_in, n_in > 0 ? in_sizes[0] : -1, out_size, ws_size, (size_t)WS_NEED); grid = -1; return; }
        int dev = 0, cus = 0, per_cu = 0;
        if (hipGetDevice(&dev) != hipSuccess || hipDeviceGetAttribute(&cus, hipDeviceAttributeMultiprocessorCount, dev) != hipSuccess) { grid = -1; return; }
        if (hipFuncSetAttribute((const void*)hybrid_fwd, hipFuncAttributeMaxDynamicSharedMemorySize, LDS_BYTES) != hipSuccess) { fprintf(stderr, "kernel_launch: hipFuncSetAttribute failed\n"); grid = -1; return; }
        if (hipOccupancyMaxActiveBlocksPerMultiprocessor(&per_cu, (const void*)hybrid_fwd, 512, LDS_BYTES) != hipSuccess || per_cu < 1)
            fprintf(stderr, "kernel_launch: note: occupancy query reports %d workgroups per CU\n", per_cu);
        (void)hipGetLastError();
        grid = cus;
    }
    if (grid < 0) return;
    if (hipMemsetAsync((char*)d_ws + WS_CTL, 0, CTL_BYTES, stream) != hipSuccess) return;
    Params P; memset(&P, 0, sizeof(P));
    const float** f = (const float**)&P;
    for (int i = 0; i < 30; ++i) f[i] = (const float*)d_in[i];
    P.out = (float*)d_out; P.ws = (unsigned char*)d_ws;
#if MK_PER_PHASE
    for (int ph = 0; ph < DBG_NPH; ++ph) { P.ph_lo = ph; P.ph_hi = ph + 1; hipLaunchKernelGGL(hybrid_fwd, dim3(grid), dim3(512), LDS_BYTES, stream, P); }
#ifdef DBG_DUMP_OFF
    hipLaunchKernelGGL(dbg_dump, dim3(2048), dim3(256), 0, stream, (const unsigned char*)d_ws, (float*)d_out);
#endif
#else
    P.ph_lo = 0; P.ph_hi = NPH;
    hipLaunchKernelGGL(hybrid_fwd, dim3(grid), dim3(512), LDS_BYTES, stream, P);
#endif
}
```

```cpp
#include <hip/hip_runtime.h>
#include <cstdio>
#include <cstdint>
#include <cstring>

#ifndef MK_PER_PHASE
#define MK_PER_PHASE 0
#endif

#ifndef I8_UP
#define I8_UP 1
#endif
#ifndef FP8_FFN
#define FP8_FFN 1
#endif
#define LAS __attribute__((address_space(3)))
typedef unsigned short bf16_t;
typedef short bf16x8 __attribute__((ext_vector_type(8)));
typedef float f32x4 __attribute__((ext_vector_type(4)));
typedef float f32x2 __attribute__((ext_vector_type(2)));
typedef float f32x16 __attribute__((ext_vector_type(16)));
typedef unsigned u32x4 __attribute__((ext_vector_type(4)));
typedef unsigned u32x2 __attribute__((ext_vector_type(2)));

constexpr int DM = 1024, NB = 8, SEQ = 4096, CTXL = 256;
constexpr int TPB = CTXL + SEQ;
constexpr int T = NB * TPB;
constexpr int NTILE = T / 256;
constexpr int NLT = NB * 16;
constexpr int DSSD = 2048, NH = 32, HDIM = 64, NGRP = 4, NST = 128, CHK = 128;
constexpr int NCB = TPB / CHK;
constexpr int NCHUNK = NB * NCB;
constexpr int DXBC = 3072, DIN = 9280, OFF_XBC = 2048, OFF_DT = 5120, OFF_U = 5184, OFF_V = 6208, OFF_GATE = 7232;
constexpr int DFF = 2816, NE = 8, DFFE = 3584;
constexpr int NG1 = 3328, NG2 = 6144;
constexpr float EPS = 1e-6f;
constexpr int MOE_MAXT = 264;
constexpr int MOE_SPLIT = 128, MOE_HALF = 136;

constexpr size_t MiB = 1u << 20;
constexpr size_t WS_CTL = 0, CTL_BYTES = 1 * MiB;
constexpr size_t WS_MOD = 1 * MiB;
constexpr size_t WS_SA = 1 * MiB + 512 * 1024, WS_SA2 = 1 * MiB + 704 * 1024;
constexpr size_t WS_CTXRES = 2 * MiB;
constexpr size_t WS_WL = 10 * MiB, WL_STRIDE = 19 * MiB;
constexpr size_t WL_G1 = 0, WL_G2 = 4 * MiB, WL_W1 = 10 * MiB, WL_W2 = 14 * MiB, WL_WO = 16 * MiB, WL_SP = 18 * MiB;
constexpr size_t WS_FGU = 48 * MiB, WS_FD = 54 * MiB;
constexpr size_t WS_SSQ1 = 57 * MiB, WS_SSQ2 = 62 * MiB, WS_DT = 65 * MiB;
constexpr size_t WS_TOKE = 74 * MiB, WS_TOKP = 75 * MiB, WS_TOKS = 76 * MiB, WS_CNTB = 77 * MiB;
constexpr size_t WS_SW = 77 * MiB + 256 * 1024;
constexpr int SW_L = NG1 + NG2, SW_FGU = 2 * SW_L, SW_MOE = SW_FGU + 2 * DFF;
constexpr size_t D_WMOE = 78 * MiB;
constexpr size_t WS_D = 162 * MiB;
#ifndef I8_IN
#define I8_IN I8_UP
#endif
constexpr int IN_MODE = I8_IN ? 2 : 0;
#ifndef I8_FFN
#define I8_FFN I8_UP
#endif
constexpr int UP_MODE = I8_FFN ? 2 : (FP8_FFN ? 1 : 0);
constexpr int DN_MODE = FP8_FFN ? 1 : 0;
constexpr int INESZ = IN_MODE ? 1 : 2, UPESZ = UP_MODE ? 1 : 2, FESZ = DN_MODE ? 1 : 2;
static_assert(IN_MODE == 2 && UP_MODE == 2 && DN_MODE == 1, "the workspace map below assumes int8 input/up projections and fp8 down projections");
constexpr size_t D_H = WS_D, D_XBC = WS_D + 34 * MiB, D_XT = WS_D + 238 * MiB, D_BT = WS_D + 374 * MiB, D_CM = WS_D + 408 * MiB, D_CB = WS_D + 442 * MiB;
constexpr size_t D_Y = WS_D + 34 * MiB, D_V = WS_D + 170 * MiB, D_G = WS_D + 238 * MiB, D_U = WS_D + 374 * MiB, D_MG = WS_D + 170 * MiB;
constexpr size_t D_H2 = WS_D, D_HD = WS_D + 238 * MiB;
constexpr size_t D_H2M = WS_D, D_H2S = WS_D + 32 * MiB, D_HDM = WS_D + 98 * MiB, D_O = WS_D + 217 * MiB;
constexpr size_t WS_NEED = WS_D + 476 * MiB;
constexpr size_t WMOE_UP = (size_t)2 * DFFE * DM * UPESZ, WMOE_E = WMOE_UP + (size_t)DM * DFFE * FESZ;
static_assert((size_t)T * 3072 * 2 <= 204 * MiB && (size_t)T * 2048 * 2 <= 136 * MiB && (size_t)T * 1024 * 2 <= 68 * MiB && (size_t)T * DM * INESZ <= 34 * MiB, "map");
static_assert((size_t)T * DFF * FESZ <= 136 * MiB && (size_t)MOE_MAXT * 256 * 2048 <= 132 * MiB && (size_t)MOE_HALF * 256 * DFFE * FESZ <= 119 * MiB && NE * WMOE_E <= 84 * MiB && (size_t)MOE_MAXT * 256 * DM * UPESZ <= 66 * MiB, "map2");
static_assert((size_t)NG1 * DM * INESZ <= 4 * MiB && (size_t)NG2 * DM * INESZ <= 6 * MiB && (size_t)2 * DFF * DM * UPESZ <= 6 * MiB && (size_t)DM * DFF * FESZ <= 3 * MiB, "map3");
constexpr int E8_ONE = 0x7F7F7F7F, E8_W = 0x79797979  , E8_HD = 0x7D7D7D7D  ;

constexpr int LDS_BYTES = 151552;
constexpr int LDS_MISC = 150528;

typedef __bf16 bf16x2_t __attribute__((ext_vector_type(2)));
__device__ __forceinline__ unsigned cvt_pk_bf16(float lo, float hi) { f32x2 v = {lo, hi}; bf16x2_t b = __builtin_convertvector(v, bf16x2_t); return __builtin_bit_cast(unsigned, b); }
__device__ __forceinline__ float fclamp127(float v) { return __builtin_fminf(__builtin_fmaxf(v, -127.f), 127.f); }
__device__ __forceinline__ float fclamp8(float v) { return __builtin_fminf(__builtin_fmaxf(v, -448.f), 448.f); }
__device__ __forceinline__ unsigned cvt_pk4_fp8(float a, float b, float c, float d) { int w = 0; w = __builtin_amdgcn_cvt_pk_fp8_f32(fclamp8(a), fclamp8(b), w, false); w = __builtin_amdgcn_cvt_pk_fp8_f32(fclamp8(c), fclamp8(d), w, true); return (unsigned)w; }
__device__ __forceinline__ float bf_lo(unsigned w) { return __uint_as_float(w << 16); }
__device__ __forceinline__ float bf_hi(unsigned w) { return __uint_as_float(w & 0xffff0000u); }
__device__ __forceinline__ float bf2f(bf16_t b) { return __uint_as_float(((unsigned)b) << 16); }
__device__ __forceinline__ bf16_t f2bf(float f) { return (bf16_t)(cvt_pk_bf16(f, 0.f) & 0xffffu); }
__device__ __forceinline__ float frcp(float x) { return __builtin_amdgcn_rcpf(x); }
__device__ __forceinline__ float fsigmoid(float x) { return frcp(1.0f + __expf(-x)); }
__device__ __forceinline__ float fsilu(float x) { return x * frcp(1.0f + __expf(-x)); }
__device__ __forceinline__ float fgelu(float x) { const float u = 1.5957691216057308f * (x + 0.044715f * x * x * x); return x * frcp(1.0f + __expf(-u)); }
__device__ __forceinline__ float fsoftplus(float x) {
    const float e = __expf(-__builtin_fabsf(x)); const float l = e < 0.0078125f ? e * (1.0f - e * (0.5f - e * 0.33333334f)) : __logf(1.0f + e); return __builtin_fmaxf(x, 0.f) + l; }
__device__ __forceinline__ float shx(float v, int mask, int lane) { return __int_as_float(__builtin_amdgcn_ds_bpermute((lane ^ mask) << 2, __float_as_int(v))); }
#define WR_DPP(v, ctrl, rmask, bc) __int_as_float(__builtin_amdgcn_update_dpp(0, __float_as_int(v), (ctrl), (rmask), 0xF, (bc)))
__device__ __forceinline__ float wave_max(float v, int lane) {
    (void)lane;
    v = __builtin_fmaxf(v, WR_DPP(v, 0x111, 0xF, true)); v = __builtin_fmaxf(v, WR_DPP(v, 0x112, 0xF, true)); v = __builtin_fmaxf(v, WR_DPP(v, 0x114, 0xF, true)); v = __builtin_fmaxf(v, WR_DPP(v, 0x118, 0xF, true));
    v = __builtin_fmaxf(v, WR_DPP(v, 0x142, 0xA, false)); v = __builtin_fmaxf(v, WR_DPP(v, 0x143, 0xC, false));
    return __int_as_float(__builtin_amdgcn_readlane(__float_as_int(v), 63));
}
__device__ __forceinline__ unsigned pack_i8x4(float a, float b, float c, float d, float inv) {
    const int ia = (int)__builtin_rintf(fclamp127(a * inv)), ib = (int)__builtin_rintf(fclamp127(b * inv)), ic = (int)__builtin_rintf(fclamp127(c * inv)), id = (int)__builtin_rintf(fclamp127(d * inv));
    return (unsigned)(ia & 255) | ((unsigned)(ib & 255) << 8) | ((unsigned)(ic & 255) << 16) | ((unsigned)id << 24);
}
__device__ __forceinline__ float wave_sum(float v, int lane) {
    (void)lane;
    v += WR_DPP(v, 0x111, 0xF, true); v += WR_DPP(v, 0x112, 0xF, true); v += WR_DPP(v, 0x114, 0xF, true); v += WR_DPP(v, 0x118, 0xF, true);
    v += WR_DPP(v, 0x142, 0xA, false); v += WR_DPP(v, 0x143, 0xC, false);
    return __int_as_float(__builtin_amdgcn_readlane(__float_as_int(v), 63));
}

#define XB_TMO      128
#define XB_XCNT(j)  (256  + 64 * (j))
#define XB_XSUB(j)  (1280 + 64 * (j))
#define XB_XGEN(j)  (2304 + 64 * (j))
#define XB_TOP      3328
#define XB_TOPGEN   3392
#define XCD_BAR_WORDS 3456
#define XB_SPIN_CAP (1u << 24)
__device__ __forceinline__ unsigned xb_ld(unsigned* p)              { return __hip_atomic_load(p, __ATOMIC_RELAXED, __HIP_MEMORY_SCOPE_AGENT); }
__device__ __forceinline__ unsigned xb_add(unsigned* p, unsigned v) { return __hip_atomic_fetch_add(p, v, __ATOMIC_RELAXED, __HIP_MEMORY_SCOPE_AGENT); }
__device__ __forceinline__ unsigned xb_xcc_id() { return (unsigned)__builtin_amdgcn_s_getreg((3 << 11) | 20) & 0xFu; }
#define XB_SPIN(cond, bar) do { unsigned _sp = 0; while (cond) { __builtin_amdgcn_s_sleep(1); \
    if ((++_sp & 255u) == 0u) { if (xb_ld(&(bar)[XB_TMO])) break; if (_sp > XB_SPIN_CAP) { atomicAdd(&(bar)[XB_TMO], 1u); break; } } } } while (0)
struct XcdBarrier { unsigned* bar; unsigned x; volatile LAS unsigned* st; };
__device__ __forceinline__ XcdBarrier xcd_barrier_post(unsigned* bar, volatile LAS unsigned* st) {
    XcdBarrier b; b.bar = bar; b.x = xb_xcc_id(); b.st = st;
    if (threadIdx.x == 0) (void)xb_add(&bar[XB_XCNT(b.x)], 1u);
    return b;
}
__device__ __forceinline__ void xcd_barrier_complete(unsigned* bar, unsigned x, unsigned& nloc, unsigned& nx) {
    const unsigned G = gridDim.x * gridDim.y * gridDim.z;
    unsigned sum, cnt, mine, sp = 0u;
    for (;;) {
        sum = 0u; cnt = 0u; mine = 0u;
#pragma unroll
        for (unsigned j = 0; j < 16; ++j) { const unsigned c = xb_ld(&bar[XB_XCNT(j)]); sum += c; cnt += (c > 0u) ? 1u : 0u; mine = (j == x) ? c : mine; }
        if (sum == G) break;
        __builtin_amdgcn_s_sleep(1);
        if ((++sp & 255u) == 0u) { if (xb_ld(&bar[XB_TMO])) break; if (sp > XB_SPIN_CAP) { atomicAdd(&bar[XB_TMO], 1u); break; } }
    }
    nloc = mine > 0u ? mine : 1u; nx = cnt > 0u ? cnt : 1u;
}
__device__ __forceinline__ void xcd_barrier(const XcdBarrier& b) {
    asm volatile("s_waitcnt vmcnt(0)" ::: "memory");
    __syncthreads();
    if (threadIdx.x == 0) {
        unsigned* bar = b.bar;
        __builtin_amdgcn_s_waitcnt(0);
        unsigned nloc = b.st[0], nx = b.st[1];
        if (nloc == 0u) { xcd_barrier_complete(bar, b.x, nloc, nx); b.st[0] = nloc; b.st[1] = nx; }
        const unsigned old = xb_add(&bar[XB_XSUB(b.x)], 1u);
        const unsigned gen = old / nloc;
        if (old + 1u == (gen + 1u) * nloc) {
            __builtin_amdgcn_fence(__ATOMIC_RELEASE, "agent");
            asm volatile("s_waitcnt vmcnt(0)" ::: "memory");
            const unsigned og = xb_add(&bar[XB_TOP], 1u);
            const unsigned tg = og / nx;
            if (og + 1u == (tg + 1u) * nx) xb_add(&bar[XB_TOPGEN], 1u);
            else XB_SPIN(xb_ld(&bar[XB_TOPGEN]) == tg, bar);
            __builtin_amdgcn_fence(__ATOMIC_ACQUIRE, "agent");
            xb_add(&bar[XB_XGEN(b.x)], 1u);
            asm volatile("s_waitcnt vmcnt(0)" ::: "memory");
        } else {
            XB_SPIN(xb_ld(&bar[XB_XGEN(b.x)]) == gen, bar);
            __builtin_amdgcn_fence(__ATOMIC_ACQUIRE, "agent");
            asm volatile("s_waitcnt vmcnt(0)" ::: "memory");
        }
    }
    __syncthreads();
}
namespace pg8 {
constexpr int BM = 256, BK = 64, HALF = 128, HTB = HALF * BK * 2, STAGE_BYTES = 8 * HTB, NXCD = 8, WGM = 8;
__host__ __device__ __forceinline__ int lds_byte(int r, int c) { const int st = (r >> 4) * 2 + (c >> 5), rr = r & 15, cc = c & 31, ob = rr * 64 + cc * 2; return st * 1024 + (ob ^ (((ob >> 9) & 1) << 5)); }
__host__ __device__ __forceinline__ void stage_rc(int b, int& R, int& C) { const int st = b / 1024, sb = b % 1024, swz = sb ^ (((sb >> 9) & 1) << 5); R = (st >> 1) * 16 + swz / 64; C = (st & 1) * 32 + (swz % 64) / 2; }
__host__ __device__ __forceinline__ int perm32(int rho) { const int n = rho >> 4, i = rho & 15; return 8 * (i >> 2) + 4 * n + (i & 3); }

struct Unit { int rt, pn, seg, last, lda, ldb, nt; const char* a; const char* b; };

struct Sched {
    int nM, nN, G, c, nseg, lat_only, tm0;
    const char* A0; const char* A1; const char* B0; const char* B1; int lda0, lda1, K0, K1;
    const int* tileE; size_t bstrideE; const LAS int* tileL = nullptr;
    template <int NSEG> __device__ __forceinline__ bool next(int j, Unit& u) const {
        const int jj = (NSEG == 2) ? (j >> 1) : j, seg = (NSEG == 2) ? (j & 1) : 0;
        const int nwg = nM * nN; const long L = (long)jj * G + c; if (L >= nwg) return false;
        int wgid = (int)L; { const int q = nwg / NXCD, r = nwg % NXCD, xcd = wgid % NXCD, off = wgid / NXCD; wgid = (xcd < r ? xcd * (q + 1) : r * (q + 1) + (xcd - r) * q) + off; }
        const int nig = WGM * nN, gid = wgid / nig, fm = gid * WGM, gsz = (nM - fm) < WGM ? (nM - fm) : WGM;
        const int tm = fm + ((wgid % nig) % gsz), pn = (wgid % nig) / gsz;
        int rt = tm0 + tm; if (lat_only) rt = (tm >> 4) * 17 + (tm & 15) + 1;
        u.rt = rt; u.pn = pn; u.seg = seg; u.last = (seg == NSEG - 1) ? 1 : 0;
        const int lda = seg ? lda1 : lda0, K = seg ? K1 : K0;
        u.a = (seg ? A1 : A0) + (size_t)rt * 256 * lda;
        const char* bb = seg ? B1 : B0; if (tileL) bb += (size_t)tileL[rt] * bstrideE; else if (tileE) bb += (size_t)tileE[rt] * bstrideE;
        u.b = bb + (size_t)pn * 256 * K; u.lda = lda; u.ldb = K; u.nt = K / 128;
        return true;
    }
};

typedef int i32x8 __attribute__((ext_vector_type(8)));
typedef int i32x4 __attribute__((ext_vector_type(4)));
template <class Epi, bool VAR_LD = false, int MODE = 0, bool ALIGN_EPI = true>
__device__ __forceinline__ void gemm_phase(LAS unsigned char* lds, int tid_in, const Sched& S, const Epi& E) {
    constexpr bool FP8 = (MODE == 1), I8 = (MODE == 2);
    const int tid = tid_in, wid = __builtin_amdgcn_readfirstlane(tid >> 6), lane = tid & 63, wr = wid >> 2, wc = wid & 3, fr = lane & 15, fq = lane >> 4;
#define PG8_VOFF(U, vA0_, vA1_, vB0_, vB1_) do { int t2_ = tid; asm volatile("" : "+v"(t2_)); int R_, C_; \
        stage_rc(t2_ * 16, R_, C_); { const int Rb_ = Epi::PERM ? ((R_ & ~31) + perm32(R_ & 31)) : R_; vA0_ = (unsigned)(R_ * (U).lda + C_ * 2); vB0_ = (unsigned)(Rb_ * (U).ldb + C_ * 2); } \
        stage_rc(t2_ * 16 + 8192, R_, C_); { const int Rb_ = Epi::PERM ? ((R_ & ~31) + perm32(R_ & 31)) : R_; vA1_ = (unsigned)(R_ * (U).lda + C_ * 2); vB1_ = (unsigned)(Rb_ * (U).ldb + C_ * 2); } } while (0)
    const size_t kstep = (size_t)(BK * 2);
    const unsigned ldsw = (unsigned)wid * 1024u;
    const int aoff = lds_byte(wr * 64 + fr, fq * 8), boff = lds_byte(wc * 32 + fr, fq * 8);
#define PG8_SA(b, h) (((b) * 2 + (h)) * HTB)
#define PG8_SB(b, h) ((4 + (b) * 2 + (h)) * HTB)
#define PG8_STAGE(bufoff, gbase, v0, v1) do { \
        __builtin_amdgcn_global_load_lds((const unsigned*)((const char*)(gbase) + (v0)), (LAS unsigned*)(lds + (bufoff) + ldsw), 16, 0, 0); \
        __builtin_amdgcn_global_load_lds((const unsigned*)((const char*)(gbase) + (v1)), (LAS unsigned*)(lds + (bufoff) + ldsw + 8192), 16, 0, 0); } while (0)
#define PG8_LD8(p0, p1) __builtin_shufflevector(*(const LAS i32x4*)(p0), *(const LAS i32x4*)(p1), 0, 1, 2, 3, 4, 5, 6, 7)
#define PG8_LDA(dst, b, h) do { _Pragma("unroll") for (int m = 0; m < 4; ++m) dst[m] = PG8_LD8(lds + PG8_SA(b, h) + aoff + m * 2048, lds + PG8_SA(b, h) + aoff + m * 2048 + 1024); } while (0)
#define PG8_LDB(dst, b, h) do { _Pragma("unroll") for (int n = 0; n < 2; ++n) dst[n] = PG8_LD8(lds + PG8_SB(b, h) + boff + n * 2048, lds + PG8_SB(b, h) + boff + n * 2048 + 1024); } while (0)
#define PG8_HALFI(x, k) __builtin_shufflevector((x), (x), 4 * (k), 4 * (k) + 1, 4 * (k) + 2, 4 * (k) + 3)
#define PG8_HALF(x, k) __builtin_bit_cast(bf16x8, __builtin_shufflevector((x), (x), 4 * (k), 4 * (k) + 1, 4 * (k) + 2, 4 * (k) + 3))
#define PG8_MMA(ai, bj, At, Bt) do { __builtin_amdgcn_s_setprio(1); if constexpr (FP8) { _Pragma("unroll") for (int m = 0; m < 4; ++m) _Pragma("unroll") for (int n = 0; n < 2; ++n) \
        asm volatile("v_mfma_scale_f32_16x16x128_f8f6f4 %0, %1, %2, %0, %3, %4 op_sel_hi:[0,0,0]" : "+v"(acc[ai][bj][m][n]) : "v"(Bt[n]), "v"(At[m]), "v"(sc_w), "v"(sc_x)); } \
      else if constexpr (I8) { _Pragma("unroll") for (int m = 0; m < 4; ++m) _Pragma("unroll") for (int n = 0; n < 2; ++n) { \
        i32x4 c_ = __builtin_bit_cast(i32x4, acc[ai][bj][m][n]); \
        c_ = __builtin_amdgcn_mfma_i32_16x16x64_i8(PG8_HALFI(Bt[n], 0), PG8_HALFI(At[m], 0), c_, 0, 0, 0); \
        c_ = __builtin_amdgcn_mfma_i32_16x16x64_i8(PG8_HALFI(Bt[n], 1), PG8_HALFI(At[m], 1), c_, 0, 0, 0); \
        acc[ai][bj][m][n] = __builtin_bit_cast(f32x4, c_); } } \
      else { _Pragma("unroll") for (int m = 0; m < 4; ++m) _Pragma("unroll") for (int n = 0; n < 2; ++n) { \
        acc[ai][bj][m][n] = __builtin_amdgcn_mfma_f32_16x16x32_bf16(PG8_HALF(Bt[n], 0), PG8_HALF(At[m], 0), acc[ai][bj][m][n], 0, 0, 0); \
        acc[ai][bj][m][n] = __builtin_amdgcn_mfma_f32_16x16x32_bf16(PG8_HALF(Bt[n], 1), PG8_HALF(At[m], 1), acc[ai][bj][m][n], 0, 0, 0); } } __builtin_amdgcn_s_setprio(0); } while (0)
#define PG8_WAIT_V(n) asm volatile("s_waitcnt vmcnt(" #n ")" ::: "memory")
#define PG8_WAIT_L(n) asm volatile("s_waitcnt lgkmcnt(" #n ")" ::: "memory")
#define PG8_BAR __builtin_amdgcn_s_barrier()
#define PG8_SCHED __builtin_amdgcn_sched_barrier(0)
    Unit cur, nxt; int ui = 0;
    int sc_w = 0, sc_x = 0; if constexpr (FP8) { sc_w = Epi::SCALE_W; sc_x = Epi::SCALE_X; asm volatile("" : "+v"(sc_w), "+v"(sc_x)); }
    constexpr int NSEG = VAR_LD ? 2 : 1;
    if (!S.template next<NSEG>(0, cur)) return;
    f32x4 acc[2][2][4][2];
#pragma unroll
    for (int a = 0; a < 2; ++a)
#pragma unroll
        for (int b = 0; b < 2; ++b)
#pragma unroll
            for (int m = 0; m < 4; ++m)
#pragma unroll
                for (int n = 0; n < 2; ++n) acc[a][b][m][n] = (f32x4){0.f, 0.f, 0.f, 0.f};
    i32x8 At[4], B0[2], B1[2];
    const char* cA = cur.a; const char* cB = cur.b;
    unsigned cvA0, cvA1, cvB0, cvB1; PG8_VOFF(cur, cvA0, cvA1, cvB0, cvB1);
    size_t chA = (size_t)HALF * cur.lda, chB = (size_t)HALF * cur.ldb;
    PG8_STAGE(PG8_SB(0, 0), cB, cvB0, cvB1); PG8_STAGE(PG8_SB(0, 1), cB + chB, cvB0, cvB1); PG8_STAGE(PG8_SA(0, 0), cA, cvA0, cvA1); PG8_STAGE(PG8_SA(0, 1), cA + chA, cvA0, cvA1);
    if (wr == 1) PG8_BAR;
    PG8_WAIT_V(2); PG8_BAR;
    PG8_STAGE(PG8_SB(1, 0), cB + kstep, cvB0, cvB1); PG8_STAGE(PG8_SA(1, 0), cA + kstep, cvA0, cvA1); PG8_STAGE(PG8_SB(1, 1), cB + chB + kstep, cvB0, cvB1);
    PG8_WAIT_V(6); PG8_BAR;
    for (;;) {
        const bool has_next = S.template next<NSEG>(ui + 1, nxt);
        if (!has_next) nxt = cur;
        const char* nA = nxt.a; const char* nB = nxt.b;
        unsigned nvA0 = cvA0, nvA1 = cvA1, nvB0 = cvB0, nvB1 = cvB1; size_t nhA = chA, nhB = chB;
        if constexpr (VAR_LD) { PG8_VOFF(nxt, nvA0, nvA1, nvB0, nvB1); nhA = (size_t)HALF * nxt.lda; nhB = (size_t)HALF * nxt.ldb; }
        const int nt = cur.nt;
        for (int t = 0; t < nt; t += 2) {
            const bool last = (t == nt - 2);
            const char* a1 = cA + (size_t)(t + 1) * kstep;
            const char* a2 = last ? nA : cA + (size_t)(t + 2) * kstep; const char* b2 = last ? nB : cB + (size_t)(t + 2) * kstep;
            const char* a3 = a2 + kstep; const char* b3 = b2 + kstep;
            const unsigned vA0 = last ? nvA0 : cvA0, vA1 = last ? nvA1 : cvA1, vB0 = last ? nvB0 : cvB0, vB1 = last ? nvB1 : cvB1;
            const size_t hA = last ? nhA : chA, hB = last ? nhB : chB;
            PG8_LDB(B0, 0, 0); PG8_LDB(B1, 0, 1); PG8_SCHED; PG8_LDA(At, 0, 0); PG8_STAGE(PG8_SA(1, 1), a1 + chA, cvA0, cvA1);
            PG8_WAIT_V(8); PG8_WAIT_L(0); PG8_BAR; PG8_MMA(0, 0, At, B0); PG8_MMA(0, 1, At, B1); PG8_BAR; PG8_SCHED;
            PG8_LDA(At, 0, 1); PG8_STAGE(PG8_SB(0, 0), b2, vB0, vB1); PG8_STAGE(PG8_SB(0, 1), b2 + hB, vB0, vB1); PG8_STAGE(PG8_SA(0, 0), a2, vA0, vA1);
            PG8_WAIT_V(8); PG8_WAIT_L(0); PG8_BAR; PG8_MMA(1, 0, At, B0); PG8_MMA(1, 1, At, B1); PG8_BAR; PG8_SCHED;
            PG8_LDB(B0, 1, 0); PG8_LDB(B1, 1, 1); PG8_SCHED; PG8_LDA(At, 1, 0); PG8_STAGE(PG8_SA(0, 1), a2 + hA, vA0, vA1);
            PG8_WAIT_V(8); PG8_WAIT_L(0); PG8_BAR; PG8_MMA(0, 0, At, B0); PG8_MMA(0, 1, At, B1); PG8_BAR; PG8_SCHED;
            PG8_LDA(At, 1, 1); PG8_STAGE(PG8_SB(1, 0), b3, vB0, vB1); PG8_STAGE(PG8_SB(1, 1), b3 + hB, vB0, vB1); PG8_STAGE(PG8_SA(1, 0), a3, vA0, vA1);
            PG8_WAIT_V(8); PG8_WAIT_L(0); PG8_BAR; PG8_MMA(1, 0, At, B0); PG8_MMA(1, 1, At, B1); PG8_BAR; PG8_SCHED;
        }
        { unsigned m_ = ~0u; asm volatile("" : "+s"(m_)); const int l2_ = (int)__builtin_amdgcn_mbcnt_hi(m_, __builtin_amdgcn_mbcnt_lo(m_, 0u));
            const typename Epi::Pre pre = E.prefetch(cur, wr, wc, l2_ & 15, l2_ >> 4);
            if constexpr (ALIGN_EPI) { if (wr == 0) PG8_BAR; }
            if constexpr (FP8) asm volatile("s_nop 15\n\ts_nop 15" ::: "memory");
            E(acc, cur, wr, wc, l2_ & 15, l2_ >> 4, pre); }
        if (!has_next) break;
        if (cur.last) {
#pragma unroll
            for (int a = 0; a < 2; ++a)
#pragma unroll
                for (int b = 0; b < 2; ++b)
#pragma unroll
                    for (int m = 0; m < 4; ++m)
#pragma unroll
                        for (int n = 0; n < 2; ++n) acc[a][b][m][n] = (f32x4){0.f, 0.f, 0.f, 0.f};
        }
        cur = nxt; cA = nA; cB = nB; cvA0 = nvA0; cvA1 = nvA1; cvB0 = nvB0; cvB1 = nvB1; chA = nhA; chB = nhB; ++ui;
        if constexpr (ALIGN_EPI) { if (wr == 1) PG8_BAR; }
    }
    PG8_WAIT_V(0);
    if constexpr (!ALIGN_EPI) { if (wr == 0) PG8_BAR; }
    PG8_BAR;
#undef PG8_VOFF
#undef PG8_SA
#undef PG8_SB
#undef PG8_STAGE
#undef PG8_LDA
#undef PG8_LDB
#undef PG8_MMA
#undef PG8_HALF
#undef PG8_HALFI
#undef PG8_LD8
#undef PG8_WAIT_V
#undef PG8_WAIT_L
#undef PG8_BAR
#undef PG8_SCHED
}
}
struct Params {
    const float* x; const float* c; const float* ctx; const float* c_ctx; const float* w_ada; const float* b_ada; const float* norm1_g; const float* w_in;
    const float* conv_w; const float* conv_b; const float* dt_bias; const float* a_log; const float* d_skip; const float* ssd_norm_g; const float* w_ssd_br;
    const float* gm_norm_g; const float* w_spatial; const float* b_spatial; const float* w_gm_br; const float* w_out; const float* norm2_g;
    const float* ffn_w_gate; const float* ffn_w_up; const float* ffn_w_down; const float* moe_router_w; const float* moe_router_b;
    const float* moe_w_gate; const float* moe_w_up; const float* moe_w_down; const float* final_norm_g;
    float* out; unsigned char* ws; int ph_lo, ph_hi;
};

struct Ctx {
    LAS unsigned char* lds; int tid, lane, wave, G, bid;
};

__device__ __forceinline__ const float* res_in_row(const Params& p, int state, int row) {
    const int b = row / TPB, i = row - b * TPB;
    if (i < CTXL) return (state ? (const float*)(p.ws + WS_CTXRES) : p.ctx) + (size_t)(b * CTXL + i) * DM;
    return (state ? (const float*)p.out : p.x) + (size_t)(b * SEQ + (i - CTXL)) * DM;
}
__device__ __forceinline__ float* res_out_row(const Params& p, int row) {
    const int b = row / TPB, i = row - b * TPB;
    if (i < CTXL) return (float*)(p.ws + WS_CTXRES) + (size_t)(b * CTXL + i) * DM;
    return p.out + (size_t)(b * SEQ + (i - CTXL)) * DM;
}
__device__ __forceinline__ const float* mod_vec(const Params& p, int layer, int row_tile, int k) {
    const int b = row_tile / 17, j = row_tile - b * 17; const int bm = (j == 0) ? 8 : b;
    return (const float*)(p.ws + WS_MOD) + ((size_t)(layer * 9 + bm) * 6 + k) * DM;
}

__device__ __forceinline__ void mod_unit(const Params& p, const Ctx& F, int unit) {
    const int layer = unit / 96, slab = unit - layer * 96;
    LAS float* sv = (LAS float*)F.lds;
    LAS float* red = (LAS float*)(F.lds + 9 * 1024 * 4);
    __syncthreads();
    for (int i = F.tid; i < 9 * 1024; i += 512) { const int r = i >> 10, k = i & 1023; const float v = (r < 8) ? p.c[r * DM + k] : p.c_ctx[k]; sv[i] = fsilu(v); }
    __syncthreads();
    const int cg = F.lane & 15, ks = F.wave * 4 + (F.lane >> 4);
    const float* W = p.w_ada + (size_t)layer * DM * 6144 + slab * 64 + cg * 4;
    f32x4 acc[9];
#pragma unroll
    for (int r = 0; r < 9; ++r) acc[r] = (f32x4){0.f, 0.f, 0.f, 0.f};
    f32x4 wv[32];
#pragma unroll
    for (int kk = 0; kk < 32; ++kk) wv[kk] = *(const f32x4*)(W + (size_t)(ks * 32 + kk) * 6144);
#pragma unroll
    for (int kk = 0; kk < 32; ++kk) {
        const int k = ks * 32 + kk;
        const f32x4 w = wv[kk];
#pragma unroll
        for (int r = 0; r < 9; ++r) acc[r] += w * sv[r * 1024 + k];
    }
#pragma unroll
    for (int r = 0; r < 9; ++r)
#pragma unroll
        for (int j = 0; j < 4; ++j) { float v = acc[r][j]; v += shx(v, 16, F.lane); v += shx(v, 32, F.lane); acc[r][j] = v; }
    if (F.lane < 16) {
#pragma unroll
        for (int r = 0; r < 9; ++r)
#pragma unroll
            for (int j = 0; j < 4; ++j) red[(F.wave * 9 + r) * 64 + cg * 4 + j] = acc[r][j];
    }
    __syncthreads();
    for (int i = F.tid; i < 9 * 64; i += 512) {
        const int r = i >> 6, cidx = i & 63; float s = 0.f;
#pragma unroll
        for (int w = 0; w < 8; ++w) s += red[(w * 9 + r) * 64 + cidx];
        const int col = slab * 64 + cidx;
        ((float*)(p.ws + WS_MOD))[(size_t)(layer * 9 + r) * 6144 + col] = s + p.b_ada[layer * 6144 + col];
    }
}

struct CvtJob { const float* src; int ld, K, c0, ncols; bf16_t* dst; int drow0, inter; const float* gain; float f8scale; float* sw; };
__device__ __forceinline__ int cvt_job_ntiles(const CvtJob& J) { return J.sw ? (J.ncols / 64) : (J.K / 128) * (J.ncols / 64); }
__device__ __forceinline__ int cvt_drow(const CvtJob& J, int j0) { return J.inter ? ((j0 >> 7) * 256 + (j0 & 127) + (J.inter - 1) * 128) : (J.drow0 + j0); }
__device__ __forceinline__ void cvt_fetch(const Ctx& F, const float* src, int ld, int k0, int n0, f32x4 (&r)[4]) {
    const int kk = F.tid >> 4, n4 = (F.tid & 15) * 4;
#pragma unroll
    for (int h = 0; h < 4; ++h) r[h] = *(const f32x4*)(src + (size_t)(k0 + kk + 32 * h) * ld + n0 + n4);
}
__device__ __forceinline__ void cvt_to_lds(const Ctx& F, LAS float* tile, const f32x4 (&r)[4]) {
    const int kk = F.tid >> 4, n4 = (F.tid & 15) * 4;
#pragma unroll
    for (int h = 0; h < 4; ++h) { const int k = kk + h * 32; tile[k * 65 + n4] = r[h][0]; tile[k * 65 + n4 + 1] = r[h][1]; tile[k * 65 + n4 + 2] = r[h][2]; tile[k * 65 + n4 + 3] = r[h][3]; }
}
__device__ __forceinline__ void cvt_emit(const Ctx& F, const LAS float* tile, const CvtJob& J, int drow, int k0, float i8inv) {
    const int nn = F.tid >> 3, ks = (F.tid & 7) * 16; float v[16];
#pragma unroll
    for (int j = 0; j < 16; ++j) { v[j] = tile[(ks + j) * 65 + nn]; if (J.gain) v[j] *= J.gain[k0 + ks + j]; }
    if (J.sw) { *(u32x4*)((unsigned char*)J.dst + (size_t)(drow + nn) * J.K + k0 + ks) = (u32x4){pack_i8x4(v[0], v[1], v[2], v[3], i8inv), pack_i8x4(v[4], v[5], v[6], v[7], i8inv), pack_i8x4(v[8], v[9], v[10], v[11], i8inv), pack_i8x4(v[12], v[13], v[14], v[15], i8inv)}; }
    else if (J.f8scale != 0.f) { const float f = J.f8scale; *(u32x4*)((unsigned char*)J.dst + (size_t)(drow + nn) * J.K + k0 + ks) = (u32x4){cvt_pk4_fp8(v[0] * f, v[1] * f, v[2] * f, v[3] * f), cvt_pk4_fp8(v[4] * f, v[5] * f, v[6] * f, v[7] * f), cvt_pk4_fp8(v[8] * f, v[9] * f, v[10] * f, v[11] * f), cvt_pk4_fp8(v[12] * f, v[13] * f, v[14] * f, v[15] * f)}; }
    else { bf16_t* d = J.dst + (size_t)(drow + nn) * J.K + k0 + ks;
        *(u32x4*)d = (u32x4){cvt_pk_bf16(v[0], v[1]), cvt_pk_bf16(v[2], v[3]), cvt_pk_bf16(v[4], v[5]), cvt_pk_bf16(v[6], v[7])};
        *(u32x4*)(d + 8) = (u32x4){cvt_pk_bf16(v[8], v[9]), cvt_pk_bf16(v[10], v[11]), cvt_pk_bf16(v[12], v[13]), cvt_pk_bf16(v[14], v[15])}; }
}
__device__ __forceinline__ void cvt_run(const Ctx& F, const CvtJob& J, int first, int stride) {
    LAS float* tile = (LAS float*)F.lds;
    const int n = cvt_job_ntiles(J);
    if (first >= n) return;
    if (!J.sw) {
        const int nk = J.K / 128; f32x4 r[4];
        cvt_fetch(F, J.src, J.ld, (first % nk) * 128, J.c0 + (first / nk) * 64, r);
        for (int t = first; t < n; t += stride) {
            const int k0 = (t % nk) * 128, j0 = (t / nk) * 64, drow = cvt_drow(J, j0);
            __syncthreads();
            cvt_to_lds(F, tile, r);
            const int tn = t + stride; if (tn < n) cvt_fetch(F, J.src, J.ld, (tn % nk) * 128, J.c0 + (tn / nk) * 64, r);
            __syncthreads();
            cvt_emit(F, tile, J, drow, k0, 0.f);
        }
    } else {
        LAS float* red = tile + 128 * 65;
        const int kk = F.tid >> 4, n4 = (F.tid & 15) * 4, K = J.K;
        for (int t = first; t < n; t += stride) {
            const int n0 = J.c0 + t * 64, drow = cvt_drow(J, t * 64);
            f32x4 mx = (f32x4){0.f, 0.f, 0.f, 0.f};
#pragma unroll 32
            for (int k = kk; k < K; k += 32) { const f32x4 v = *(const f32x4*)(J.src + (size_t)k * J.ld + n0 + n4);
#pragma unroll
                for (int j = 0; j < 4; ++j) mx[j] = __builtin_fmaxf(mx[j], __builtin_fabsf(v[j])); }
            __syncthreads();
#pragma unroll
            for (int j = 0; j < 4; ++j) red[kk * 64 + n4 + j] = mx[j];
            __syncthreads();
            if (F.tid < 64) { float m = 0.f;
#pragma unroll
                for (int q = 0; q < 32; ++q) m = __builtin_fmaxf(m, red[q * 64 + F.tid]);
                const float scl = m > 0.f ? m * (1.0f / 127.f) : 1.0f; J.sw[drow + F.tid] = scl; red[2048 + F.tid] = 1.0f / scl; }
            f32x4 r[4]; cvt_fetch(F, J.src, J.ld, 0, n0, r);
            for (int k0 = 0; k0 < K; k0 += 128) {
                __syncthreads();
                cvt_to_lds(F, tile, r);
                if (k0 + 128 < K) cvt_fetch(F, J.src, J.ld, k0 + 128, n0, r);
                __syncthreads();
                cvt_emit(F, tile, J, drow, k0, red[2048 + (F.tid >> 3)]);
            }
        }
    }
}

constexpr int NJOB0 = 2 * 9 + 3;
__device__ __forceinline__ CvtJob prologue_job(const Params& p, int j) {
    CvtJob J{};
    if (j < 18) {
        const int l = j / 9, q = j - l * 9; unsigned char* wl = p.ws + WS_WL + (size_t)l * WL_STRIDE;
        const float* win = p.w_in + (size_t)l * DM * DIN;
        J.ld = DIN; J.K = DM; J.src = win; J.inter = 0; J.gain = nullptr;
        float* swl = (float*)(p.ws + WS_SW) + l * SW_L; if (I8_IN && q < 6) J.sw = (q < 2) ? swl : swl + NG1;
        switch (q) {
        case 0: J.c0 = OFF_XBC; J.ncols = DXBC; J.dst = (bf16_t*)(wl + WL_G1); J.drow0 = 0; break;
        case 1: J.c0 = OFF_DT; J.ncols = 64; J.dst = (bf16_t*)(wl + WL_G1); J.drow0 = 3072; break;
        case 2: J.c0 = 0; J.ncols = 2048; J.dst = (bf16_t*)(wl + WL_G2); J.drow0 = 0; break;
        case 3: J.c0 = OFF_GATE; J.ncols = 2048; J.dst = (bf16_t*)(wl + WL_G2); J.drow0 = 2048; break;
        case 4: J.c0 = OFF_U; J.ncols = 1024; J.dst = (bf16_t*)(wl + WL_G2); J.drow0 = 4096; break;
        case 5: J.c0 = OFF_V; J.ncols = 1024; J.dst = (bf16_t*)(wl + WL_G2); J.drow0 = 5120; break;
        case 6: J.src = p.w_ssd_br + (size_t)l * DSSD * DM; J.ld = DM; J.K = DSSD; J.c0 = 0; J.ncols = DM; J.dst = (bf16_t*)(wl + WL_W1); J.drow0 = 0; J.gain = p.ssd_norm_g + l * DSSD; break;
        case 7: J.src = p.w_gm_br + (size_t)l * DM * DM; J.ld = DM; J.K = DM; J.c0 = 0; J.ncols = DM; J.dst = (bf16_t*)(wl + WL_W2); J.drow0 = 0; break;
        default: J.src = p.w_out + (size_t)l * DM * DM; J.ld = DM; J.K = DM; J.c0 = 0; J.ncols = DM; J.dst = (bf16_t*)(wl + WL_WO); J.drow0 = 0; break;
        }
    } else if (j == 18) { J.src = p.ffn_w_gate; J.ld = DFF; J.K = DM; J.c0 = 0; J.ncols = DFF; J.dst = (bf16_t*)(p.ws + WS_FGU); J.drow0 = 0; J.inter = 1; J.gain = nullptr; J.f8scale = UP_MODE == 1 ? 64.f : 0.f; if (UP_MODE == 2) J.sw = (float*)(p.ws + WS_SW) + SW_FGU; }
    else if (j == 19) { J.src = p.ffn_w_up; J.ld = DFF; J.K = DM; J.c0 = 0; J.ncols = DFF; J.dst = (bf16_t*)(p.ws + WS_FGU); J.drow0 = 0; J.inter = 2; J.gain = nullptr; J.f8scale = UP_MODE == 1 ? 64.f : 0.f; if (UP_MODE == 2) J.sw = (float*)(p.ws + WS_SW) + SW_FGU; }
    else { J.src = p.ffn_w_down; J.ld = DM; J.K = DFF; J.c0 = 0; J.ncols = DM; J.dst = (bf16_t*)(p.ws + WS_FD); J.drow0 = 0; J.inter = 0; J.gain = nullptr; J.f8scale = DN_MODE == 1 ? 64.f : 0.f; }
    return J;
}
__device__ __forceinline__ void convert_jobs(const Params& p, const Ctx& F, int j0, int j1, int wid, int nw) {
    int base = 0;
    for (int j = j0; j < j1; ++j) {
        const CvtJob J = prologue_job(p, j); const int n = cvt_job_ntiles(J);
        cvt_run(F, J, (wid - base % nw + nw) % nw, nw);
        base += n;
    }
}
__device__ __forceinline__ void phase_prologue(const Params& p, const Ctx& F, bool with_l1) {
    for (int u = F.bid; u < 192; u += F.G) mod_unit(p, F, u);
    convert_jobs(p, F, 0, 9, F.bid, F.G); if (with_l1) convert_jobs(p, F, 9, 18, F.bid, F.G); convert_jobs(p, F, 18, NJOB0, F.bid, F.G);
    for (int l = 0; l < 2; ++l) {
        unsigned char* wl = p.ws + WS_WL + (size_t)l * WL_STRIDE;
        u32x4* z = (u32x4*)(wl + WL_G1 + (size_t)3136 * DM * INESZ);
        for (int i = F.bid * 512 + F.tid; i < 192 * DM * INESZ / 16; i += F.G * 512) z[i] = (u32x4){0u, 0u, 0u, 0u};
        if (I8_IN && F.bid == 0 && F.tid < 192) ((float*)(p.ws + WS_SW))[l * SW_L + 3136 + F.tid] = 1.0f;
        const float* sp = p.w_spatial + (size_t)l * 8 * 128 * 128; u32x2* d = (u32x2*)(wl + WL_SP);
        for (int i = F.bid * 512 + F.tid; i < 8 * 128 * 128 / 4; i += F.G * 512) { const f32x4 v = *(const f32x4*)(sp + (size_t)i * 4); d[i] = (u32x2){cvt_pk_bf16(v[0], v[1]), cvt_pk_bf16(v[2], v[3])}; }
    }
}
__device__ __forceinline__ void moe_weight_convert(const Params& p, const Ctx& F, int e_lo, int e_hi, int wid, int nw) {
    int base = 0;
    for (int j = 3 * e_lo; j < 3 * e_hi; ++j) {
        const int e = j / 3, q = j - e * 3; CvtJob J{};
        unsigned char* we = p.ws + D_WMOE + (size_t)e * WMOE_E;
        if (q == 0) { J.src = p.moe_w_gate + (size_t)e * DM * DFFE; J.ld = DFFE; J.K = DM; J.c0 = 0; J.ncols = DFFE; J.dst = (bf16_t*)we; J.inter = 1; J.f8scale = UP_MODE == 1 ? 64.f : 0.f; if (UP_MODE == 2) J.sw = (float*)(p.ws + WS_SW) + SW_MOE + e * 2 * DFFE; }
        else if (q == 1) { J.src = p.moe_w_up + (size_t)e * DM * DFFE; J.ld = DFFE; J.K = DM; J.c0 = 0; J.ncols = DFFE; J.dst = (bf16_t*)we; J.inter = 2; J.f8scale = UP_MODE == 1 ? 64.f : 0.f; if (UP_MODE == 2) J.sw = (float*)(p.ws + WS_SW) + SW_MOE + e * 2 * DFFE; }
        else { J.src = p.moe_w_down + (size_t)e * DFFE * DM; J.ld = DM; J.K = DFFE; J.c0 = 0; J.ncols = DM; J.dst = (bf16_t*)(we + WMOE_UP); J.drow0 = 0; J.inter = 0; J.f8scale = DN_MODE == 1 ? 64.f : 0.f; }
        J.gain = nullptr;
        const int n = cvt_job_ntiles(J);
        cvt_run(F, J, (wid - base % nw + nw) % nw, nw);
        base += n;
    }
}

__device__ __forceinline__ void phase_norm(const Params& p, const Ctx& F, int layer, int state, const float* g, int kshift, bf16_t* H, bool lat_only, int mode = 0, float* SA = nullptr) {
    (void)lat_only;
    const int nw = F.G * 8; int pr = F.bid * 8 + F.wave;
    if (2 * pr >= T) return;
    f32x4 gg[4];
#pragma unroll
    for (int q = 0; q < 4; ++q) gg[q] = *(const f32x4*)(g + q * 256 + F.lane * 4);
    f32x4 v[2][4], s1[4], s0[4], vn[2][4], s1n[4], s0n[4];
    { const float* xr = res_in_row(p, state, 2 * pr); const float* sh = mod_vec(p, layer, (2 * pr) >> 8, kshift); const float* sc = mod_vec(p, layer, (2 * pr) >> 8, kshift + 1);
#pragma unroll
      for (int q = 0; q < 4; ++q) { vn[0][q] = *(const f32x4*)(xr + q * 256 + F.lane * 4); vn[1][q] = *(const f32x4*)(xr + DM + q * 256 + F.lane * 4); s1n[q] = *(const f32x4*)(sc + q * 256 + F.lane * 4); s0n[q] = *(const f32x4*)(sh + q * 256 + F.lane * 4); } }
    for (; 2 * pr < T; pr += nw) {
#pragma unroll
        for (int q = 0; q < 4; ++q) { v[0][q] = vn[0][q]; v[1][q] = vn[1][q]; s1[q] = s1n[q]; s0[q] = s0n[q]; }
        const int rn = 2 * (pr + nw);
        if (rn < T) { const float* xr = res_in_row(p, state, rn); const float* sh = mod_vec(p, layer, rn >> 8, kshift); const float* sc = mod_vec(p, layer, rn >> 8, kshift + 1);
#pragma unroll
            for (int q = 0; q < 4; ++q) { vn[0][q] = *(const f32x4*)(xr + q * 256 + F.lane * 4); vn[1][q] = *(const f32x4*)(xr + DM + q * 256 + F.lane * 4); s1n[q] = *(const f32x4*)(sc + q * 256 + F.lane * 4); s0n[q] = *(const f32x4*)(sh + q * 256 + F.lane * 4); } }
        float ss[2] = {0.f, 0.f};
#pragma unroll
        for (int e = 0; e < 2; ++e)
#pragma unroll
            for (int q = 0; q < 4; ++q) ss[e] += v[e][q][0] * v[e][q][0] + v[e][q][1] * v[e][q][1] + v[e][q][2] * v[e][q][2] + v[e][q][3] * v[e][q][3];
        { ss[0] = wave_sum(ss[0], F.lane); ss[1] = wave_sum(ss[1], F.lane); }
        float am[2] = {0.f, 0.f};
#pragma unroll
        for (int e = 0; e < 2; ++e) { const float rs = rsqrtf(ss[e] * (1.0f / DM) + EPS);
#pragma unroll
            for (int q = 0; q < 4; ++q) {
                v[e][q] = v[e][q] * rs * gg[q] * (s1[q] + 1.0f) + s0[q];
                am[e] = __builtin_fmaxf(am[e], __builtin_fmaxf(__builtin_fmaxf(__builtin_fabsf(v[e][q][0]), __builtin_fabsf(v[e][q][1])), __builtin_fmaxf(__builtin_fabsf(v[e][q][2]), __builtin_fabsf(v[e][q][3]))));
            } }
        float inv[2] = {0.f, 0.f};
        if (mode == 2) {
            { am[0] = wave_max(am[0], F.lane); am[1] = wave_max(am[1], F.lane); }
#pragma unroll
            for (int e = 0; e < 2; ++e) { const float scl = am[e] > 0.f ? am[e] * (1.0f / 127.f) : 1.0f; inv[e] = 1.0f / scl; if (F.lane == 0) SA[2 * pr + e] = scl; }
        }
#pragma unroll
        for (int e = 0; e < 2; ++e)
#pragma unroll
            for (int q = 0; q < 4; ++q) {
                const int col = q * 256 + F.lane * 4; const f32x4 o = v[e][q]; const size_t row = (size_t)(2 * pr + e);
                if (mode == 2) *(unsigned*)((unsigned char*)H + row * DM + col) = pack_i8x4(o[0], o[1], o[2], o[3], inv[e]);
                else if (mode == 1) *(unsigned*)((unsigned char*)H + row * DM + col) = cvt_pk4_fp8(o[0], o[1], o[2], o[3]);
                else *(u32x2*)(H + row * DM + col) = (u32x2){cvt_pk_bf16(o[0], o[1]), cvt_pk_bf16(o[2], o[3])};
            }
    }
}
using pg8::Unit;
typedef int i32x4q __attribute__((ext_vector_type(4)));
struct ScalePre { f32x4 sw[2][2]; float sa[2][4]; };
struct NoPre {};
template <bool PERM> __device__ __forceinline__ ScalePre scale_fetch(const float* SA, const float* SW, int row0, int colbase) {
    ScalePre P;
#pragma unroll
    for (int bj = 0; bj < 2; ++bj)
#pragma unroll
        for (int n = 0; n < 2; ++n) P.sw[bj][n] = *(const f32x4*)(SW + colbase + bj * 128 + (PERM ? 4 : 16) * n);
#pragma unroll
    for (int ai = 0; ai < 2; ++ai)
#pragma unroll
        for (int m = 0; m < 4; ++m) P.sa[ai][m] = SA[row0 + ai * 128 + m * 16];
    return P;
}
__device__ __forceinline__ void dequant_acc(f32x4 (&acc)[2][2][4][2], const ScalePre& P) {
#pragma unroll
    for (int ai = 0; ai < 2; ++ai)
#pragma unroll
        for (int m = 0; m < 4; ++m) { const float sa = P.sa[ai][m];
#pragma unroll
            for (int bj = 0; bj < 2; ++bj)
#pragma unroll
                for (int n = 0; n < 2; ++n) { const i32x4q iv = __builtin_bit_cast(i32x4q, acc[ai][bj][m][n]);
                    acc[ai][bj][m][n] = __builtin_convertvector(iv, f32x4) * (P.sw[bj][n] * sa); } }
}
struct EpiG1 {
    static constexpr bool PERM = true;
    bf16_t* XBC; float* DT; const float* dt_bias; const float* SA; const float* SW;
    typedef ScalePre Pre;
    __device__ __forceinline__ Pre prefetch(const Unit& u, int wr, int wc, int fr, int fq) const { return scale_fetch<true>(SA, SW, u.rt * 256 + wr * 64 + fr, u.pn * 256 + wc * 32 + 8 * fq); }
    __device__ __forceinline__ void operator()(f32x4 (&acc)[2][2][4][2], const Unit& u, int wr, int wc, int fr, int fq, const Pre& pre) const {
        const int row0 = u.rt * 256 + wr * 64 + fr;
        if constexpr (IN_MODE == 2) dequant_acc(acc, pre);
        if (u.pn < 12) {
            const int col0 = u.pn * 256 + wc * 32 + 8 * fq;
#pragma unroll
            for (int ai = 0; ai < 2; ++ai)
#pragma unroll
                for (int m = 0; m < 4; ++m) { bf16_t* rowp = XBC + (size_t)(row0 + ai * 128 + m * 16) * DXBC + col0;
#pragma unroll
                    for (int bj = 0; bj < 2; ++bj) { const f32x4 v0 = acc[ai][bj][m][0], v1 = acc[ai][bj][m][1];
                        u32x4 w; w.x = cvt_pk_bf16(v0[0], v0[1]); w.y = cvt_pk_bf16(v0[2], v0[3]); w.z = cvt_pk_bf16(v1[0], v1[1]); w.w = cvt_pk_bf16(v1[2], v1[3]);
                        *(u32x4*)(rowp + bj * 128) = w; } }
        } else if (wc < 2) {
            const int c0 = wc * 32 + 8 * fq;
            const f32x4 b0 = *(const f32x4*)(dt_bias + c0), b1 = *(const f32x4*)(dt_bias + c0 + 4);
#pragma unroll
            for (int ai = 0; ai < 2; ++ai)
#pragma unroll
                for (int m = 0; m < 4; ++m) { float* rowp = DT + (size_t)(row0 + ai * 128 + m * 16) * 64 + c0;
                    f32x4 v0 = acc[ai][0][m][0] + b0, v1 = acc[ai][0][m][1] + b1;
#pragma unroll
                    for (int j = 0; j < 4; ++j) { v0[j] = fsoftplus(v0[j]); v1[j] = fsoftplus(v1[j]); }
                    *(f32x4*)rowp = v0; *(f32x4*)(rowp + 4) = v1; }
        }
    }
};
struct EpiG2 {
    static constexpr bool PERM = true;
    bf16_t* Y; bf16_t* Gt; bf16_t* U; bf16_t* V; float* SSQ1; float* SSQ2; const float* SA; const float* SW;
    typedef ScalePre Pre;
    __device__ __forceinline__ Pre prefetch(const Unit& u, int wr, int wc, int fr, int fq) const { return scale_fetch<true>(SA, SW, u.rt * 256 + wr * 64 + fr, u.pn * 256 + wc * 32 + 8 * fq); }
    __device__ __forceinline__ void operator()(f32x4 (&acc)[2][2][4][2], const Unit& u, int wr, int wc, int fr, int fq, const Pre& pre) const {
        const int row0 = u.rt * 256 + wr * 64 + fr; const int pn = u.pn;
        if constexpr (IN_MODE == 2) dequant_acc(acc, pre);
        const int kind = pn < 8 ? 0 : (pn < 16 ? 1 : (pn < 20 ? 2 : 3));
        bf16_t* base; int ld, colt; float* ssq = nullptr; int sld = 0, scol = 0;
        if (kind == 0) { base = Y; ld = DSSD; colt = pn * 256; ssq = SSQ1; sld = 32; scol = pn * 4 + wc; }
        else if (kind == 1) { base = Gt; ld = 2048; colt = (pn - 8) * 256; }
        else if (kind == 2) { base = U; ld = DM; colt = (pn - 16) * 256; }
        else { base = V; ld = DM; colt = (pn - 20) * 256; ssq = SSQ2; sld = 16; scol = (pn - 20) * 4 + wc; }
        const int col0 = colt + wc * 32 + 8 * fq;
#pragma unroll
        for (int ai = 0; ai < 2; ++ai) {
            u32x4 yall[4][2];
            if (kind == 0) {
#pragma unroll
                for (int m = 0; m < 4; ++m)
#pragma unroll
                    for (int bj = 0; bj < 2; ++bj) yall[m][bj] = *(const u32x4*)(base + (size_t)(row0 + ai * 128 + m * 16) * ld + col0 + bj * 128);
            }
#pragma unroll
            for (int m = 0; m < 4; ++m) {
                const int row = row0 + ai * 128 + m * 16; bf16_t* rowp = base + (size_t)row * ld + col0; float ss = 0.f;
#pragma unroll
                for (int bj = 0; bj < 2; ++bj) {
                    f32x4 v0 = acc[ai][bj][m][0], v1 = acc[ai][bj][m][1];
                    if (kind == 0) {
                        const u32x4 yv = yall[m][bj];
                        v0[0] = bf_lo(yv.x) * fsilu(v0[0]); v0[1] = bf_hi(yv.x) * fsilu(v0[1]); v0[2] = bf_lo(yv.y) * fsilu(v0[2]); v0[3] = bf_hi(yv.y) * fsilu(v0[3]);
                        v1[0] = bf_lo(yv.z) * fsilu(v1[0]); v1[1] = bf_hi(yv.z) * fsilu(v1[1]); v1[2] = bf_lo(yv.w) * fsilu(v1[2]); v1[3] = bf_hi(yv.w) * fsilu(v1[3]);
                    } else if (kind == 1) {
#pragma unroll
                        for (int j = 0; j < 4; ++j) { v0[j] = fsigmoid(v0[j]); v1[j] = fsigmoid(v1[j]); }
                    } else if (kind == 3) {
#pragma unroll
                        for (int j = 0; j < 4; ++j) { v0[j] = fgelu(v0[j]); v1[j] = fgelu(v1[j]); }
                    }
                    ss += (v0[0] * v0[0] + v0[1] * v0[1]) + (v0[2] * v0[2] + v0[3] * v0[3]) + (v1[0] * v1[0] + v1[1] * v1[1]) + (v1[2] * v1[2] + v1[3] * v1[3]);
                    u32x4 w; w.x = cvt_pk_bf16(v0[0], v0[1]); w.y = cvt_pk_bf16(v0[2], v0[3]); w.z = cvt_pk_bf16(v1[0], v1[1]); w.w = cvt_pk_bf16(v1[2], v1[3]);
                    *(u32x4*)(rowp + bj * 128) = w;
                }
                if (ssq) { ss += shx(ss, 16, fq * 16 + fr); ss += shx(ss, 32, fq * 16 + fr); if (fq == 0) ssq[(size_t)row * sld + scol] = ss; }
            }
        }
    }
};
struct EpiMerge {
    static constexpr bool PERM = true;
    const bf16_t* Gt; const float* SSQ1; bf16_t* MG;
    typedef NoPre Pre;
    __device__ __forceinline__ Pre prefetch(const Unit&, int, int, int, int) const { return Pre{}; }
    __device__ __forceinline__ void operator()(f32x4 (&acc)[2][2][4][2], const Unit& u, int wr, int wc, int fr, int fq, const Pre&) const {
        const int row0 = u.rt * 256 + wr * 64 + fr; const int col0 = u.pn * 256 + wc * 32 + 8 * fq;
#pragma unroll
        for (int ai = 0; ai < 2; ++ai) {
            u32x4 g1v[4][2];
#pragma unroll
            for (int m = 0; m < 4; ++m)
#pragma unroll
                for (int bj = 0; bj < 2; ++bj) g1v[m][bj] = *(const u32x4*)(Gt + (size_t)(row0 + ai * 128 + m * 16) * 2048 + col0 + bj * 128 + 1024);
#pragma unroll
            for (int m = 0; m < 4; ++m) {
                const int row = row0 + ai * 128 + m * 16;
                float r1 = 1.f;
                if (u.seg == 0) {
                    const f32x4 s0 = *(const f32x4*)(SSQ1 + (size_t)row * 32 + fq * 8), s1 = *(const f32x4*)(SSQ1 + (size_t)row * 32 + fq * 8 + 4);
                    float ss = (s0[0] + s0[1]) + (s0[2] + s0[3]) + (s1[0] + s1[1]) + (s1[2] + s1[3]);
                    ss += shx(ss, 16, fq * 16 + fr); ss += shx(ss, 32, fq * 16 + fr);
                    r1 = rsqrtf(ss * (1.0f / DSSD) + EPS);
                }
#pragma unroll
                for (int bj = 0; bj < 2; ++bj) {
                    const bf16_t* gp = Gt + (size_t)row * 2048 + col0 + bj * 128;
                    const u32x4 g1 = g1v[m][bj];
                    float g1f[8] = {bf_lo(g1.x), bf_hi(g1.x), bf_lo(g1.y), bf_hi(g1.y), bf_lo(g1.z), bf_hi(g1.z), bf_lo(g1.w), bf_hi(g1.w)};
                    if (u.seg == 0) {
                        const u32x4 g0 = *(const u32x4*)gp;
                        float g0f[8] = {bf_lo(g0.x), bf_hi(g0.x), bf_lo(g0.y), bf_hi(g0.y), bf_lo(g0.z), bf_hi(g0.z), bf_lo(g0.w), bf_hi(g0.w)};
#pragma unroll
                        for (int j = 0; j < 4; ++j) { acc[ai][bj][m][0][j] *= r1 * g0f[j] * frcp(g1f[j]); acc[ai][bj][m][1][j] *= r1 * g0f[4 + j] * frcp(g1f[4 + j]); }
                    } else {
                        f32x4 v0 = acc[ai][bj][m][0], v1 = acc[ai][bj][m][1];
#pragma unroll
                        for (int j = 0; j < 4; ++j) { v0[j] *= g1f[j]; v1[j] *= g1f[4 + j]; }
                        u32x4 w; w.x = cvt_pk_bf16(v0[0], v0[1]); w.y = cvt_pk_bf16(v0[2], v0[3]); w.z = cvt_pk_bf16(v1[0], v1[1]); w.w = cvt_pk_bf16(v1[2], v1[3]);
                        *(u32x4*)(MG + (size_t)row * DM + col0 + bj * 128) = w;
                    }
                }
            }
        }
    }
};
template <int SW = 0x7F7F7F7F, int SX = 0x7F7F7F7F> struct EpiResT {
    static constexpr bool PERM = false; static constexpr int SCALE_W = SW, SCALE_X = SX;
    const float* xin_lat; const float* xin_ctx; float* xo_lat; float* xo_ctx; const float* mod; int layer, kgate;
    typedef NoPre Pre;
    __device__ __forceinline__ Pre prefetch(const Unit&, int, int, int, int) const { return Pre{}; }
    __device__ __forceinline__ void operator()(f32x4 (&acc)[2][2][4][2], const Unit& u, int wr, int wc, int fr, int fq, const Pre&) const {
        const int b = u.rt / 17, j = u.rt - b * 17; const int bm = (j == 0) ? 8 : b;
        const size_t rbase = (j == 0) ? (size_t)(b * CTXL) : (size_t)(b * SEQ + (j - 1) * 256);
        const float* xi = ((j == 0) ? xin_ctx : xin_lat) + rbase * DM; float* xo = ((j == 0) ? xo_ctx : xo_lat) + rbase * DM;
        const float* gate = mod + ((size_t)(layer * 9 + bm) * 6 + kgate) * DM;
        const int r0 = wr * 64 + fr, col0 = u.pn * 256 + wc * 32 + 4 * fq;
        f32x4 gv[2][2];
#pragma unroll
        for (int bj = 0; bj < 2; ++bj)
#pragma unroll
            for (int n = 0; n < 2; ++n) gv[bj][n] = *(const f32x4*)(gate + col0 + bj * 128 + n * 16);
#pragma unroll
        for (int ai = 0; ai < 2; ++ai) {
            f32x4 bs[4][2][2];
#pragma unroll
            for (int m = 0; m < 4; ++m)
#pragma unroll
                for (int bj = 0; bj < 2; ++bj)
#pragma unroll
                    for (int n = 0; n < 2; ++n) bs[m][bj][n] = *(const f32x4*)(xi + (size_t)(r0 + ai * 128 + m * 16) * DM + col0 + bj * 128 + n * 16);
#pragma unroll
            for (int m = 0; m < 4; ++m)
#pragma unroll
                for (int bj = 0; bj < 2; ++bj)
#pragma unroll
                    for (int n = 0; n < 2; ++n) *(f32x4*)(xo + (size_t)(r0 + ai * 128 + m * 16) * DM + col0 + bj * 128 + n * 16) = bs[m][bj][n] + gv[bj][n] * acc[ai][bj][m][n];
        }
    }
};
typedef EpiResT<> EpiRes;
template <bool F8> struct EpiGluT {
    static constexpr bool PERM = true; static constexpr int SCALE_W = E8_W, SCALE_X = E8_ONE;
    bf16_t* HD; int ld, rt0; const float* SA; const float* SW; const int* tileE; const char* B0;
    typedef ScalePre Pre;
    __device__ __forceinline__ Pre prefetch(const Unit& u, int wr, int wc, int fr, int fq) const { const float* sw = SW; if (tileE) { const size_t e = (size_t)(u.b - B0 - (size_t)u.pn * 256 * (size_t)u.ldb) / WMOE_E; sw = SW + e * 2 * DFFE; }
        return scale_fetch<true>(SA, sw, u.rt * 256 + wr * 64 + fr, u.pn * 256 + wc * 32 + 8 * fq); }
    __device__ __forceinline__ void operator()(f32x4 (&acc)[2][2][4][2], const Unit& u, int wr, int wc, int fr, int fq, const Pre& pre) const {
        const int row0 = (u.rt - rt0) * 256 + wr * 64 + fr, col0 = u.pn * 128 + wc * 32 + 8 * fq;
        if constexpr (UP_MODE == 2) dequant_acc(acc, pre);
#pragma unroll
        for (int ai = 0; ai < 2; ++ai)
#pragma unroll
            for (int m = 0; m < 4; ++m) {
                const f32x4 g0 = acc[ai][0][m][0], g1 = acc[ai][0][m][1], u0 = acc[ai][1][m][0], u1 = acc[ai][1][m][1]; f32x4 v0, v1;
#pragma unroll
                for (int j = 0; j < 4; ++j) { v0[j] = fsilu(g0[j]) * u0[j]; v1[j] = fsilu(g1[j]) * u1[j]; }
                if constexpr (F8) { *(u32x2*)((unsigned char*)HD + (size_t)(row0 + ai * 128 + m * 16) * ld + col0) = (u32x2){cvt_pk4_fp8(4.f * v0[0], 4.f * v0[1], 4.f * v0[2], 4.f * v0[3]), cvt_pk4_fp8(4.f * v1[0], 4.f * v1[1], 4.f * v1[2], 4.f * v1[3])}; }
                else { u32x4 w; w.x = cvt_pk_bf16(v0[0], v0[1]); w.y = cvt_pk_bf16(v0[2], v0[3]); w.z = cvt_pk_bf16(v1[0], v1[1]); w.w = cvt_pk_bf16(v1[2], v1[3]);
                *(u32x4*)(HD + (size_t)(row0 + ai * 128 + m * 16) * ld + col0) = w; }
            }
    }
};
typedef EpiGluT<FP8_FFN != 0> EpiGlu;
struct EpiBf {
    static constexpr bool PERM = true; static constexpr int SCALE_W = E8_W, SCALE_X = E8_HD;
    bf16_t* O; int ld;
    typedef NoPre Pre;
    __device__ __forceinline__ Pre prefetch(const Unit&, int, int, int, int) const { return Pre{}; }
    __device__ __forceinline__ void operator()(f32x4 (&acc)[2][2][4][2], const Unit& u, int wr, int wc, int fr, int fq, const Pre&) const {
        const int row0 = u.rt * 256 + wr * 64 + fr, col0 = u.pn * 256 + wc * 32 + 8 * fq;
#pragma unroll
        for (int ai = 0; ai < 2; ++ai)
#pragma unroll
            for (int m = 0; m < 4; ++m) { bf16_t* rowp = O + (size_t)(row0 + ai * 128 + m * 16) * ld + col0;
#pragma unroll
                for (int bj = 0; bj < 2; ++bj) { const f32x4 v0 = acc[ai][bj][m][0], v1 = acc[ai][bj][m][1];
                    u32x4 w; w.x = cvt_pk_bf16(v0[0], v0[1]); w.y = cvt_pk_bf16(v0[2], v0[3]); w.z = cvt_pk_bf16(v1[0], v1[1]); w.w = cvt_pk_bf16(v1[2], v1[3]);
                    *(u32x4*)(rowp + bj * 128) = w; } }
    }
};
#define MFMA32(a, b, c) __builtin_amdgcn_mfma_f32_32x32x16_bf16((a), (b), (c), 0, 0, 0)
constexpr int PITCH = 272;

__device__ __forceinline__ u32x4 conv_fetch(const bf16_t* XBC, int cc, int colbase, int id) {
    const int c = cc % NCB, j = id >> 4, q = id & 15, l = j - 2;
    const bool valid = (l >= 0 && l < CHK) || (c == 0 && l >= CHK) || (c == 1 && l < 0);
    u32x4 v = (u32x4){0u, 0u, 0u, 0u};
    if (valid) v = *(const u32x4*)(XBC + (size_t)(cc * CHK + l) * DXBC + colbase + q * 8);
    return v;
}
__device__ __forceinline__ bool conv_tap_ok(bool is_ctx, int l, int d) { return is_ctx || (((l + d - 2) >> 6) == (l >> 6)); }

__device__ __forceinline__ void conv_xs_compute(const Params& p, const Ctx& F, int layer, int cc, int s, const float (&w6)[6]) {
    (void)layer;
    bf16_t* XT = (bf16_t*)(p.ws + D_XT);
    LAS unsigned char* raw = F.lds; LAS unsigned char* stg = F.lds + 34816;
    const bool is_ctx = (cc % NCB) < 2;
    const int col = F.tid & 127;
    float w[5];
#pragma unroll
    for (int d = 0; d < 5; ++d) w[d] = w6[d];
    const float bias = w6[5];
#pragma unroll
    for (int k = 0; k < 4; ++k) {
        const int run = (F.tid >> 7) + 4 * k, l0 = run * 8;
        float in[12];
#pragma unroll
        for (int i = 0; i < 12; ++i) in[i] = bf2f(*(const LAS bf16_t*)(raw + (l0 + i) * 256 + col * 2));
        float o[8];
#pragma unroll
        for (int i = 0; i < 8; ++i) { float a = bias;
#pragma unroll
            for (int d = 0; d < 5; ++d) a += conv_tap_ok(is_ctx, l0 + i, d) ? w[d] * in[i + d] : 0.f;
            o[i] = fsilu(a); }
        u32x4 wv; wv.x = cvt_pk_bf16(o[0], o[1]); wv.y = cvt_pk_bf16(o[2], o[3]); wv.z = cvt_pk_bf16(o[4], o[5]); wv.w = cvt_pk_bf16(o[6], o[7]);
        *(LAS u32x4*)(stg + col * PITCH + l0 * 2) = wv;
    }
    __syncthreads();
    bf16_t* blk = XT + (size_t)(cc * NH + 2 * s) * HDIM * CHK;
#pragma unroll
    for (int k = 0; k < 4; ++k) { const int id = F.tid + 512 * k; *(u32x4*)(blk + (size_t)id * 8) = *(const LAS u32x4*)(stg + (id >> 4) * PITCH + (id & 15) * 16); }
}
constexpr int BC_RAWB = 0, BC_RAWC = 33792, BC_B = 67584, BC_C = 102400, BC_W = 137216;
__device__ __forceinline__ void conv_bc_compute(const Params& p, const Ctx& F, int cc, int g) {
    bf16_t* BT = (bf16_t*)(p.ws + D_BT) + (size_t)(cc * NGRP + g) * CHK * NST; bf16_t* CM = (bf16_t*)(p.ws + D_CM) + (size_t)(cc * NGRP + g) * CHK * NST; bf16_t* CB = (bf16_t*)(p.ws + D_CB) + (size_t)(cc * NGRP + g) * CHK * CHK;
    LAS unsigned char* Bc = F.lds + BC_B; LAS unsigned char* Cc = F.lds + BC_C; LAS float* W = (LAS float*)(F.lds + BC_W);
    const bool is_ctx = (cc % NCB) < 2;
#pragma unroll 2
    for (int k = 0; k < 8; ++k) {
        const int task = F.tid + 512 * k, mat = task >> 11, t2 = task & 2047, l = t2 >> 4, q = t2 & 15;
        LAS unsigned char* raw = F.lds + (mat ? BC_RAWC : BC_RAWB); const int wc = mat * 128 + q * 8;
        float a[8];
        { const f32x4 b0 = *(const LAS f32x4*)(W + 5 * 256 + wc), b1 = *(const LAS f32x4*)(W + 5 * 256 + wc + 4); a[0] = b0[0]; a[1] = b0[1]; a[2] = b0[2]; a[3] = b0[3]; a[4] = b1[0]; a[5] = b1[1]; a[6] = b1[2]; a[7] = b1[3]; }
#pragma unroll
        for (int d = 0; d < 5; ++d) {
            if (conv_tap_ok(is_ctx, l, d)) {
                const u32x4 v = *(const LAS u32x4*)(raw + (l + d) * 256 + q * 16);
                const f32x4 w0 = *(const LAS f32x4*)(W + d * 256 + wc), w1 = *(const LAS f32x4*)(W + d * 256 + wc + 4);
                a[0] += w0[0] * bf_lo(v.x); a[1] += w0[1] * bf_hi(v.x); a[2] += w0[2] * bf_lo(v.y); a[3] += w0[3] * bf_hi(v.y);
                a[4] += w1[0] * bf_lo(v.z); a[5] += w1[1] * bf_hi(v.z); a[6] += w1[2] * bf_lo(v.w); a[7] += w1[3] * bf_hi(v.w);
            }
        }
        u32x4 wv; wv.x = cvt_pk_bf16(fsilu(a[0]), fsilu(a[1])); wv.y = cvt_pk_bf16(fsilu(a[2]), fsilu(a[3])); wv.z = cvt_pk_bf16(fsilu(a[4]), fsilu(a[5])); wv.w = cvt_pk_bf16(fsilu(a[6]), fsilu(a[7]));
        *(LAS u32x4*)((mat ? Cc : Bc) + l * PITCH + q * 16) = wv;
        if (mat) *(u32x4*)(CM + (size_t)l * NST + q * 8) = wv;
    }
    __syncthreads();
#pragma unroll
    for (int k = 0; k < 4; ++k) {
        const int task = F.tid + 512 * k, n = task & 127, l0 = (task >> 7) * 8; unsigned short e[8];
#pragma unroll
        for (int i = 0; i < 8; ++i) e[i] = *(const LAS bf16_t*)(Bc + (l0 + i) * PITCH + n * 2);
        u32x4 wv; wv.x = e[0] | ((unsigned)e[1] << 16); wv.y = e[2] | ((unsigned)e[3] << 16); wv.z = e[4] | ((unsigned)e[5] << 16); wv.w = e[6] | ((unsigned)e[7] << 16);
        *(LAS u32x4*)(F.lds + BC_RAWB + n * PITCH + l0 * 2) = wv;
    }
    const int r = F.lane & 31, hh = F.lane >> 5;
#pragma unroll
    for (int tt = 0; tt < 2; ++tt) {
        const int t = F.wave * 2 + tt, si = t >> 2, li = t & 3;
        f32x16 acc; for (int i = 0; i < 16; ++i) acc[i] = 0.f;
#pragma unroll
        for (int ks = 0; ks < 8; ++ks) {
            const bf16x8 a = *(const LAS bf16x8*)(Bc + (si * 32 + r) * PITCH + ks * 32 + hh * 16);
            const bf16x8 b = *(const LAS bf16x8*)(Cc + (li * 32 + r) * PITCH + ks * 32 + hh * 16);
            acc = MFMA32(a, b, acc);
        }
#pragma unroll
        for (int m = 0; m < 2; ++m) {
            u32x2 a = (u32x2){cvt_pk_bf16(acc[8 * m], acc[8 * m + 1]), cvt_pk_bf16(acc[8 * m + 2], acc[8 * m + 3])}, bq = (u32x2){cvt_pk_bf16(acc[8 * m + 4], acc[8 * m + 5]), cvt_pk_bf16(acc[8 * m + 6], acc[8 * m + 7])};
            { auto t2 = __builtin_amdgcn_permlane32_swap(a.x, bq.x, false, false); a.x = t2[0]; bq.x = t2[1]; }
            { auto t2 = __builtin_amdgcn_permlane32_swap(a.y, bq.y, false, false); a.y = t2[0]; bq.y = t2[1]; }
            const int j = (2 * si + m - 2 * li) & 7;
            *(u32x4*)(CB + ((size_t)(li * 8 + j) * 64 + F.lane) * 8) = (u32x4){a.x, a.y, bq.x, bq.y};
        }
    }
    __syncthreads();
#pragma unroll
    for (int k = 0; k < 4; ++k) { const int id = F.tid + 512 * k; *(u32x4*)(BT + (size_t)id * 8) = *(const LAS u32x4*)(F.lds + BC_RAWB + (id >> 4) * PITCH + (id & 15) * 16); }
}
__device__ __forceinline__ void phase_conv(const Params& p, const Ctx& F, int layer) {
    const bf16_t* XBC = (const bf16_t*)(p.ws + D_XBC);
    const float* cw = p.conv_w + (size_t)layer * 5 * DXBC; const float* cb = p.conv_b + (size_t)layer * DXBC;
    {
        const int n_bc = NCHUNK * NGRP;
        u32x4 pre[9]; float wpre[3];
        int u = F.bid;
        if (u < n_bc) {
#pragma unroll
            for (int j = 0; j < 9; ++j) { const int id = F.tid + 512 * j; pre[j] = (id < 4224) ? conv_fetch(XBC, u >> 2, (id >= 2112 ? 2560 : 2048) + (u & 3) * 128, id >= 2112 ? id - 2112 : id) : (u32x4){0u, 0u, 0u, 0u}; }
#pragma unroll
            for (int j = 0; j < 3; ++j) { const int id = F.tid + 512 * j, d = id >> 8, cidx = id & 255; const int gcol = (cidx >= 128 ? 2560 + cidx - 128 : 2048 + cidx) + (u & 3) * 128; wpre[j] = d < 5 ? cw[d * DXBC + gcol] : cb[gcol]; }
        }
        for (; u < n_bc; u += F.G) {
            __syncthreads();
#pragma unroll
            for (int j = 0; j < 9; ++j) { const int id = F.tid + 512 * j; if (id < 4224) *(LAS u32x4*)(F.lds + (id >= 2112 ? BC_RAWC + (id - 2112) * 16 : BC_RAWB + id * 16)) = pre[j]; }
#pragma unroll
            for (int j = 0; j < 3; ++j) ((LAS float*)(F.lds + BC_W))[F.tid + 512 * j] = wpre[j];
            const int un = u + F.G;
            if (un < n_bc) {
#pragma unroll
                for (int j = 0; j < 9; ++j) { const int id = F.tid + 512 * j; pre[j] = (id < 4224) ? conv_fetch(XBC, un >> 2, (id >= 2112 ? 2560 : 2048) + (un & 3) * 128, id >= 2112 ? id - 2112 : id) : (u32x4){0u, 0u, 0u, 0u}; }
#pragma unroll
                for (int j = 0; j < 3; ++j) { const int id = F.tid + 512 * j, d = id >> 8, cidx = id & 255; const int gcol = (cidx >= 128 ? 2560 + cidx - 128 : 2048 + cidx) + (un & 3) * 128; wpre[j] = d < 5 ? cw[d * DXBC + gcol] : cb[gcol]; }
            }
            __syncthreads();
            conv_bc_compute(p, F, u >> 2, u & 3);
        }
    }
    {
        const int n_xs = NCHUNK * 16;
        u32x4 pre[5];
        float w6[6] = {0.f, 0.f, 0.f, 0.f, 0.f, 0.f}; int s_loaded = -1;
        int v = F.G - 1 - F.bid;
        if (v < n_xs) {
#pragma unroll
            for (int j = 0; j < 5; ++j) { const int id = F.tid + 512 * j; pre[j] = (id < 2112) ? conv_fetch(XBC, v >> 4, (v & 15) * 128, id) : (u32x4){0u, 0u, 0u, 0u}; }
        }
        for (; v < n_xs; v += F.G) {
            __syncthreads();
#pragma unroll
            for (int j = 0; j < 5; ++j) { const int id = F.tid + 512 * j; if (id < 2112) *(LAS u32x4*)(F.lds + id * 16) = pre[j]; }
            const int vn = v + F.G;
            if (vn < n_xs) {
#pragma unroll
                for (int j = 0; j < 5; ++j) { const int id = F.tid + 512 * j; pre[j] = (id < 2112) ? conv_fetch(XBC, vn >> 4, (vn & 15) * 128, id) : (u32x4){0u, 0u, 0u, 0u}; }
            }
            __syncthreads();
            if ((v & 15) != s_loaded) { s_loaded = v & 15; const int gc = s_loaded * 128 + (F.tid & 127);
#pragma unroll
                for (int d = 0; d < 5; ++d) w6[d] = cw[d * DXBC + gc];
                w6[5] = cb[gc]; }
            conv_xs_compute(p, F, layer, v >> 4, v & 15, w6);
        }
    }
}

__device__ __forceinline__ void gmlp_vmap(int t, int& sp, int& q) { const int lane = t & 63, w = t >> 6; sp = (w & 7) * 16 + (lane & 15); q = (w >> 3) * 4 + (lane >> 4); }
__device__ __forceinline__ void phase_gmlp(const Params& p, const Ctx& F, int layer, bool lat_only, bool dry = false) {
    const bf16_t* V = (const bf16_t*)(p.ws + D_V); bf16_t* U = (bf16_t*)(p.ws + D_U); const float* SSQ2 = (const float*)(p.ws + WS_SSQ2);
    LAS unsigned char* VT = F.lds; LAS float* rrb = (LAS float*)(F.lds + 34816);
    LAS float* GB = (LAS float*)(F.lds + 71680);
    LAS unsigned char* WL = F.lds + 36864; int g_loaded = -1;
    const int r = F.lane & 31, hh = F.lane >> 5;
    auto unit_ok = [&](int u) { return !(lat_only && ((u >> 3) % NCB) < 2); };
    int u = F.bid; while (u < NCHUNK * 8 && !unit_ok(u)) u += F.G;
    u32x4 pre[4]; f32x4 spre = (f32x4){0.f, 0.f, 0.f, 0.f};
    int it = 0;
    if (u < NCHUNK * 8) {
        const int cc = u >> 3, g = u & 7;
#pragma unroll
        for (int k = 0; k < 4; ++k) { int sp, q; gmlp_vmap(F.tid + 512 * k, sp, q); pre[k] = *(const u32x4*)(V + (size_t)(cc * CHK + sp) * DM + g * 128 + q * 8); }
        spre = *(const f32x4*)(SSQ2 + (size_t)(cc * CHK + (F.tid >> 2)) * 16 + (F.tid & 3) * 4);
        float a = (spre[0] + spre[1]) + (spre[2] + spre[3]); a += shx(a, 1, F.lane); a += shx(a, 2, F.lane);
        __syncthreads();
        if ((F.tid & 3) == 0) rrb[F.tid >> 2] = rsqrtf(a * (1.0f / DM) + EPS);
    }
    for (; u < NCHUNK * 8; ++it) {
        const int cc = u >> 3, g = u & 7;
        int un = u + F.G; while (un < NCHUNK * 8 && !unit_ok(un)) un += F.G;
        LAS float* rr = rrb + (it & 1) * 128; LAS float* rrn = rrb + ((it + 1) & 1) * 128;
        const bf16_t* WSP = (const bf16_t*)(p.ws + WS_WL + (size_t)layer * WL_STRIDE + WL_SP) + (size_t)g * CHK * CHK;
        const bool wload = (g != g_loaded); g_loaded = g;
        const float* gmg = p.gm_norm_g + layer * DM + g * 128;
        const float* bsp = p.b_spatial + (size_t)layer * 8 * CHK + g * CHK;
        __syncthreads();
        if (wload) {
#pragma unroll
            for (int k = 0; k < 4; ++k) { const int id = F.tid + 512 * k; *(LAS u32x4*)(WL + (id >> 4) * PITCH + (id & 15) * 16) = *(const u32x4*)(WSP + (size_t)id * 8); }
            if (F.tid < 128) { GB[F.tid] = gmg[F.tid]; GB[128 + F.tid] = bsp[F.tid]; }
            __syncthreads();
        }
#pragma unroll
        for (int k = 0; k < 4; ++k) {
            int sp, q; gmlp_vmap(F.tid + 512 * k, sp, q);
            const u32x4 v = pre[k]; const float rs = rr[sp]; const f32x4 g0 = *(const LAS f32x4*)(GB + q * 8), g1 = *(const LAS f32x4*)(GB + q * 8 + 4);
            const float f[8] = {bf_lo(v.x) * rs * g0[0], bf_hi(v.x) * rs * g0[1], bf_lo(v.y) * rs * g0[2], bf_hi(v.y) * rs * g0[3], bf_lo(v.z) * rs * g1[0], bf_hi(v.z) * rs * g1[1], bf_lo(v.w) * rs * g1[2], bf_hi(v.w) * rs * g1[3]};
#pragma unroll
            for (int e = 0; e < 8; ++e) *(LAS bf16_t*)(VT + (q * 8 + e) * PITCH + sp * 2) = f2bf(f[e]);
        }
        if (un < NCHUNK * 8) {
            const int ccn = un >> 3, gn = un & 7;
#pragma unroll
            for (int k = 0; k < 4; ++k) { int sp, q; gmlp_vmap(F.tid + 512 * k, sp, q); pre[k] = *(const u32x4*)(V + (size_t)(ccn * CHK + sp) * DM + gn * 128 + q * 8); }
            spre = *(const f32x4*)(SSQ2 + (size_t)(ccn * CHK + (F.tid >> 2)) * 16 + (F.tid & 3) * 4);
        }
        __syncthreads();
        u32x4 uwv[2][2];
#pragma unroll
        for (int tt = 0; tt < 2; ++tt) { const int t = F.wave * 2 + tt, ci = t >> 2, ti = t & 3; const bf16_t* ur = U + (size_t)(cc * CHK + ti * 32 + r) * DM + g * 128 + ci * 32 + 8 * hh;
            uwv[tt][0] = *(const u32x4*)ur; uwv[tt][1] = *(const u32x4*)(ur + 16); }
#pragma unroll
        for (int tt = 0; tt < 2; ++tt) {
            const int t = F.wave * 2 + tt, ci = t >> 2, ti = t & 3;
            f32x16 acc; for (int i = 0; i < 16; ++i) acc[i] = 0.f;
            LAS unsigned char* wrow = WL + (ti * 32 + r) * PITCH + hh * 16;
#pragma unroll
            for (int ks = 0; ks < 8; ++ks) {
                const bf16x8 a = *(const LAS bf16x8*)(VT + (ci * 32 + r) * PITCH + ks * 32 + hh * 16);
                const bf16x8 b = *(const LAS bf16x8*)(wrow + ks * 32);
                acc = MFMA32(a, b, acc);
            }
            const int tpos = ti * 32 + r; const float bb = GB[128 + tpos];
            bf16_t* urow = U + (size_t)(cc * CHK + tpos) * DM + g * 128 + ci * 32 + 8 * hh;
#pragma unroll
            for (int kk = 0; kk < 2; ++kk) {
                const u32x4 uw = uwv[tt][kk];
                u32x2 ua = (u32x2){uw.x, uw.y}, ub = (u32x2){uw.z, uw.w};
                { auto t2 = __builtin_amdgcn_permlane32_swap(ua.x, ub.x, false, false); ua.x = t2[0]; ub.x = t2[1]; }
                { auto t2 = __builtin_amdgcn_permlane32_swap(ua.y, ub.y, false, false); ua.y = t2[0]; ub.y = t2[1]; }
                const int q0 = 2 * kk, q1 = 2 * kk + 1;
                u32x2 na = (u32x2){cvt_pk_bf16(fgelu(bf_lo(ua.x)) * (acc[4 * q0] + bb), fgelu(bf_hi(ua.x)) * (acc[4 * q0 + 1] + bb)), cvt_pk_bf16(fgelu(bf_lo(ua.y)) * (acc[4 * q0 + 2] + bb), fgelu(bf_hi(ua.y)) * (acc[4 * q0 + 3] + bb))};
                u32x2 nb = (u32x2){cvt_pk_bf16(fgelu(bf_lo(ub.x)) * (acc[4 * q1] + bb), fgelu(bf_hi(ub.x)) * (acc[4 * q1 + 1] + bb)), cvt_pk_bf16(fgelu(bf_lo(ub.y)) * (acc[4 * q1 + 2] + bb), fgelu(bf_hi(ub.y)) * (acc[4 * q1 + 3] + bb))};
                { auto t2 = __builtin_amdgcn_permlane32_swap(na.x, nb.x, false, false); na.x = t2[0]; nb.x = t2[1]; }
                { auto t2 = __builtin_amdgcn_permlane32_swap(na.y, nb.y, false, false); na.y = t2[0]; nb.y = t2[1]; }
                *(u32x4*)(urow + 16 * kk) = (u32x4){na.x, na.y, nb.x, nb.y};
            }
        }
        if (un < NCHUNK * 8) { float a = (spre[0] + spre[1]) + (spre[2] + spre[3]); a += shx(a, 1, F.lane); a += shx(a, 2, F.lane); if ((F.tid & 3) == 0) rrn[F.tid >> 2] = rsqrtf(a * (1.0f / DM) + EPS); }
        u = un;
    }
}
constexpr int CH_XS = 0, CH_XW = 17408, CH_BT = 34816, CH_C = 69632, CH_H = 104448  , CH_SC = 139264  , CH_EA = 147456  ;
constexpr int SC_PF = 0, SC_QB = 128, SC_DTF = 256, SC_DTB = 384, SC_WGT = 512, SC_EROW = 640, SC_ESF = 768, SC_ESB = 896;
__device__ __forceinline__ float lane_read(float v, int src_lane) { return __int_as_float(__builtin_amdgcn_ds_bpermute(src_lane << 2, __float_as_int(v))); }
__device__ __forceinline__ float wave_scan_incl(float v, int lane) {
    (void)lane;
#define CH_DPP_ADD(ctrl, rmask, bc) v += __int_as_float(__builtin_amdgcn_update_dpp(0, __float_as_int(v), (ctrl), (rmask), 0xF, (bc)))
    CH_DPP_ADD(0x111, 0xF, true); CH_DPP_ADD(0x112, 0xF, true); CH_DPP_ADD(0x114, 0xF, true); CH_DPP_ADD(0x118, 0xF, true);
    CH_DPP_ADD(0x142, 0xA, false);
    CH_DPP_ADD(0x143, 0xC, false);
#undef CH_DPP_ADD
    return v;
}
__device__ __forceinline__ void chain_scalars(LAS float* sc, LAS float* ea, int lane, float d0, float d1, float A, bool fwd, bool state_dir) {
    const float a0 = d0 * A, a1 = d1 * A;
    const float s0 = wave_scan_incl(a0, lane); const float tot0 = __int_as_float(__builtin_amdgcn_readlane(__float_as_int(s0), 63));
    const float s1 = wave_scan_incl(a1, lane) + tot0; const float atot = __int_as_float(__builtin_amdgcn_readlane(__float_as_int(s1), 63));
    if (fwd) {
        sc[SC_PF + lane] = s0; sc[SC_PF + 64 + lane] = s1; sc[SC_DTF + lane] = d0; sc[SC_DTF + 64 + lane] = d1;
        const float e0 = lane_read(s0, lane | 15), e1 = lane_read(s1, lane | 15);
        sc[SC_ESF + lane] = __expf(e0 - s0) * d0; sc[SC_ESF + 64 + lane] = __expf(e1 - s1) * d1;
        if (state_dir) { sc[SC_WGT + lane] = __expf(atot - s0) * d0; sc[SC_WGT + 64 + lane] = __expf(atot - s1) * d1; sc[SC_EROW + lane] = __expf(s0); sc[SC_EROW + 64 + lane] = __expf(s1); if (lane == 0) ea[0] = __expf(atot); }
    } else {
        const float q0 = s0 - a0, q1 = s1 - a1;
        sc[SC_QB + lane] = q0; sc[SC_QB + 64 + lane] = q1; sc[SC_DTB + lane] = d0; sc[SC_DTB + 64 + lane] = d1;
        const float b0 = lane_read(q0, lane & ~15), b1 = lane_read(q1, lane & ~15);
        sc[SC_ESB + lane] = __expf(q0 - b0) * d0; sc[SC_ESB + 64 + lane] = __expf(q1 - b1) * d1;
        if (state_dir) { sc[SC_WGT + lane] = __expf(q0) * d0; sc[SC_WGT + 64 + lane] = __expf(q1) * d1; sc[SC_EROW + lane] = __expf(atot - q0); sc[SC_EROW + 64 + lane] = __expf(atot - q1); if (lane == 0) ea[0] = __expf(atot); }
    }
}
template <int pass>
__device__ __forceinline__ void chain_write_tiles(LAS unsigned char* L, int tid, const LAS float* sc, const u32x4 (&xv)[2], const u32x4 (&bv)[4], const u32x4 (&cv)[4]) {
#pragma unroll
    for (int k = 0; k < 2; ++k) { const int id = tid + 512 * k, pp = id >> 4, q = id & 15;
        if (pass) *(LAS u32x4*)(L + CH_XS + pp * PITCH + q * 16) = xv[k];
        const f32x4 w0 = *(const LAS f32x4*)(sc + SC_WGT + q * 8), w1 = *(const LAS f32x4*)(sc + SC_WGT + q * 8 + 4);
        u32x4 o; o.x = cvt_pk_bf16(bf_lo(xv[k].x) * w0[0], bf_hi(xv[k].x) * w0[1]); o.y = cvt_pk_bf16(bf_lo(xv[k].y) * w0[2], bf_hi(xv[k].y) * w0[3]);
        o.z = cvt_pk_bf16(bf_lo(xv[k].z) * w1[0], bf_hi(xv[k].z) * w1[1]); o.w = cvt_pk_bf16(bf_lo(xv[k].w) * w1[2], bf_hi(xv[k].w) * w1[3]);
        *(LAS u32x4*)(L + CH_XW + pp * PITCH + q * 16) = o; }
#pragma unroll
    for (int k = 0; k < 4; ++k) { const int id = tid + 512 * k, rw = id >> 4, q = id & 15;
        *(LAS u32x4*)(L + CH_BT + rw * PITCH + q * 16) = bv[k]; *(LAS u32x4*)(L + CH_C + rw * PITCH + q * 16) = cv[k]; }
}
#define CH_LDS_BARRIER() asm volatile("s_waitcnt lgkmcnt(0)\n\ts_barrier" ::: "memory")
template <int pass>
__device__ __forceinline__ void chain_pass(const Params& p, const Ctx& F, int layer, int unit) {
    const int b = unit >> 5, h = unit & 31, g = h >> 3;
    const bf16_t* XT = (const bf16_t*)(p.ws + D_XT); const bf16_t* BT = (const bf16_t*)(p.ws + D_BT); const bf16_t* CM = (const bf16_t*)(p.ws + D_CM); const bf16_t* CB = (const bf16_t*)(p.ws + D_CB);
    const float* DT = (const float*)(p.ws + WS_DT); bf16_t* Y = (bf16_t*)(p.ws + D_Y);
    LAS unsigned char* L = F.lds;
    const float Af = -__expf(p.a_log[layer * 64 + h]), Ab = -__expf(p.a_log[layer * 64 + 32 + h]), Dsk = p.d_skip[layer * 32 + h];
    const int pj = F.wave & 1, li = F.wave >> 1;
    const int dcol = pass ? ((F.wave & 1) ? 32 + h : h) : 32 + h;
#define CH_LANE_VARS int tid_ = F.tid; asm volatile("" : "+v"(tid_)); const int lane_ = tid_ & 63, r = lane_ & 31, hh = lane_ >> 5, lcol = li * 32 + r; const size_t yoff = (size_t)lcol * DSSD + h * HDIM + pj * 32 + 8 * hh  , sto = (size_t)(tid_ >> 4) * DSSD + h * HDIM + (tid_ & 15) * 4  ; (void)yoff; (void)sto; (void)r; (void)hh;
    f32x16 hst;
    __syncthreads();
    for (int i = F.tid; i < 64 * PITCH / 16; i += 512) *(LAS u32x4*)(L + CH_H + i * 16) = (u32x4){0u, 0u, 0u, 0u};
#pragma unroll
    for (int i = 0; i < 16; ++i) hst[i] = 0.f;
    u32x4 xv[2], bv[4], cv[4], cbv[8]; u32x2 stv[4]; float nd0, nd1;
#define CH_CIDX(s) (pass ? (s) : ((s) < 2 ? 1 - (s) : 35 - (s)))
#define CH_ISSUE_CB(ca) do { \
        if (pass) { const bf16_t* cbrow = CB + (size_t)((ca) * NGRP + g) * CHK * CHK + ((size_t)li * 512 + lane_) * 8; const bf16_t* yr = Y + (size_t)(ca) * CHK * DSSD + sto; \
            _Pragma("unroll") for (int j = 0; j < 8; ++j) cbv[j] = *(const u32x4*)(cbrow + j * 512); \
            _Pragma("unroll") for (int q = 0; q < 4; ++q) stv[q] = *(const u32x2*)(yr + (size_t)q * 32 * DSSD); } } while (0)
    {
        CH_LANE_VARS
        const int cc = b * NCB + CH_CIDX(0);
        LAS float* sc = (LAS float*)(L + CH_SC); LAS float* ea = (LAS float*)(L + CH_EA);
        { const u32x4* xs = (const u32x4*)(XT + (size_t)(cc * NH + h) * HDIM * CHK); const u32x4* bs = (const u32x4*)(BT + (size_t)(cc * NGRP + g) * CHK * NST); const u32x4* cs = (const u32x4*)(CM + (size_t)(cc * NGRP + g) * CHK * NST);
#pragma unroll
          for (int k = 0; k < 2; ++k) xv[k] = xs[tid_ + 512 * k];
#pragma unroll
          for (int k = 0; k < 4; ++k) { bv[k] = bs[tid_ + 512 * k]; cv[k] = cs[tid_ + 512 * k]; } }
        nd0 = DT[(size_t)(cc * CHK + lane_) * 64 + dcol]; nd1 = DT[(size_t)(cc * CHK + 64 + lane_) * 64 + dcol];
        if (F.wave == 0) chain_scalars(sc, ea, lane_, nd0, nd1, pass ? Af : Ab, pass != 0, true);
        else if (F.wave == 1 && pass) chain_scalars(sc, ea, lane_, nd0, nd1, Ab, false, false);
        __syncthreads();
        chain_write_tiles<pass>(L, tid_, sc, xv, bv, cv);
        CH_ISSUE_CB(cc);
    }
#pragma unroll 1
    for (int step = 0;; ++step) {
        CH_LANE_VARS
        const int cc = b * NCB + CH_CIDX(step), row0 = cc * CHK;
        const int sn = step + 1;
        LAS float* sc = (LAS float*)(L + CH_SC + (step & 1) * 4096); LAS float* scn = (LAS float*)(L + CH_SC + (sn & 1) * 4096);
        LAS float* ea = (LAS float*)(L + CH_EA + (step & 1) * 16); LAS float* ean = (LAS float*)(L + CH_EA + (sn & 1) * 16);
        LAS unsigned char* hB = L + CH_H + (step & 1) * 17408; LAS unsigned char* hBn = L + CH_H + (sn & 1) * 17408;
        CH_LDS_BARRIER();
        const int s1c = sn < NCB ? sn : NCB - 1; const int ccn = b * NCB + CH_CIDX(s1c);
        const u32x4* xs = (const u32x4*)(XT + (size_t)(ccn * NH + h) * HDIM * CHK) + tid_; const u32x4* bs = (const u32x4*)(BT + (size_t)(ccn * NGRP + g) * CHK * NST) + tid_; const u32x4* cs = (const u32x4*)(CM + (size_t)(ccn * NGRP + g) * CHK * NST) + tid_;
        f32x16 yo, yd;
#pragma unroll
        for (int i = 0; i < 16; ++i) yo[i] = 0.f;
        {
            bf16x8 a = *(const LAS bf16x8*)(hB + (pj * 32 + r) * PITCH + hh * 16), bb = *(const LAS bf16x8*)(L + CH_C + lcol * PITCH + hh * 16);
#pragma unroll
            for (int ks = 0; ks < 8; ++ks) {
                bf16x8 an = a, bn = bb;
                if (ks < 7) { an = *(const LAS bf16x8*)(hB + (pj * 32 + r) * PITCH + (ks + 1) * 32 + hh * 16); bn = *(const LAS bf16x8*)(L + CH_C + lcol * PITCH + (ks + 1) * 32 + hh * 16); }
                else { an = *(const LAS bf16x8*)(L + CH_BT + (li * 32 + r) * PITCH + hh * 16); bn = *(const LAS bf16x8*)(L + CH_XW + (pj * 32 + r) * PITCH + hh * 16); }
                yo = MFMA32(a, bb, yo);
                if (ks == 0) nd0 = DT[(size_t)(ccn * CHK + lane_) * 64 + dcol]; else if (ks == 1) nd1 = DT[(size_t)(ccn * CHK + 64 + lane_) * 64 + dcol]; else if (ks < 4) xv[ks - 2] = xs[512 * (ks - 2)]; else bv[ks - 4] = bs[512 * (ks - 4)];
                __builtin_amdgcn_sched_barrier(0);
                a = an; bb = bn;
            }
            { const float eav = ea[0];
#pragma unroll
              for (int i = 0; i < 16; ++i) hst[i] *= eav; }
#pragma unroll
            for (int ks = 0; ks < 8; ++ks) {
                bf16x8 an = a, bn = bb;
                if (ks < 7) { an = *(const LAS bf16x8*)(L + CH_BT + (li * 32 + r) * PITCH + (ks + 1) * 32 + hh * 16); bn = *(const LAS bf16x8*)(L + CH_XW + (pj * 32 + r) * PITCH + (ks + 1) * 32 + hh * 16); }
                hst = MFMA32(a, bb, hst);
                if (ks < 4) cv[ks] = cs[512 * ks];
                __builtin_amdgcn_sched_barrier(0);
                a = an; bb = bn;
            }
        }
#pragma unroll
        for (int q = 0; q < 4; ++q)
            *(LAS u32x2*)(hBn + (pj * 32 + r) * PITCH + (li * 32 + 8 * q + 4 * hh) * 2) = (u32x2){cvt_pk_bf16(hst[4 * q], hst[4 * q + 1]), cvt_pk_bf16(hst[4 * q + 2], hst[4 * q + 3])};
        { const float er = sc[SC_EROW + lcol];
#pragma unroll
          for (int q = 0; q < 4; ++q) {
              yd[4 * q] = er * yo[4 * q]; yd[4 * q + 1] = er * yo[4 * q + 1]; yd[4 * q + 2] = er * yo[4 * q + 2]; yd[4 * q + 3] = er * yo[4 * q + 3];
              if (pass) { yd[4 * q] += bf_lo(stv[q].x); yd[4 * q + 1] += bf_hi(stv[q].x); yd[4 * q + 2] += bf_lo(stv[q].y); yd[4 * q + 3] += bf_hi(stv[q].y); }
          } }
        if (pass) {
            const bf16_t* cbrow_n = CB + (size_t)(ccn * NGRP + g) * CHK * CHK + ((size_t)li * 512 + lane_) * 8  ; const bf16_t* yr_n = Y + (size_t)ccn * CHK * DSSD + sto;
            int lcl = lcol; asm volatile("" : "+v"(lcl));
            const float pfl = sc[SC_PF + lcol], qbl = sc[SC_QB + lcol], dtbl = sc[SC_DTB + lcol];
#pragma unroll
            for (int j = 0; j < 8; ++j) {
                const int ks = (2 * li + j) & 7, s0 = ks * 16 + hh * 8;
                const float cbf[8] = {bf_lo(cbv[j].x), bf_hi(cbv[j].x), bf_lo(cbv[j].y), bf_hi(cbv[j].y), bf_lo(cbv[j].z), bf_hi(cbv[j].z), bf_lo(cbv[j].w), bf_hi(cbv[j].w)};
                float mv[8];
                if (j < 2) {
                    const f32x4 pf0 = *(const LAS f32x4*)(sc + SC_PF + s0), pf1 = *(const LAS f32x4*)(sc + SC_PF + s0 + 4), qb0 = *(const LAS f32x4*)(sc + SC_QB + s0), qb1 = *(const LAS f32x4*)(sc + SC_QB + s0 + 4);
                    const f32x4 df0 = *(const LAS f32x4*)(sc + SC_DTF + s0), df1 = *(const LAS f32x4*)(sc + SC_DTF + s0 + 4), db0 = *(const LAS f32x4*)(sc + SC_DTB + s0), db1 = *(const LAS f32x4*)(sc + SC_DTB + s0 + 4);
#pragma unroll
                    for (int e = 0; e < 8; ++e) {
                        const int sp = s0 + e; const float pfs = e < 4 ? pf0[e] : pf1[e - 4], qbs = e < 4 ? qb0[e] : qb1[e - 4], dfs = e < 4 ? df0[e] : df1[e - 4], dbs = e < 4 ? db0[e] : db1[e - 4];
                        const float arg = (sp <= lcl) ? (pfl - pfs) : (qbs - qbl);
                        float m = cbf[e] * __expf(arg) * ((sp <= lcl) ? dfs : dbs);
                        if (sp == lcl) m += cbf[e] * dtbl + Dsk;
                        mv[e] = m;
                    }
                } else {
                    const bool fwd = ks < 2 * li;
                    const float x = sc[fwd ? SC_PF + ks * 16 + 15 : SC_QB + ks * 16];
                    const float el = __expf(fwd ? pfl - x : x - qbl);
                    const LAS float* es = sc + (fwd ? SC_ESF : SC_ESB) + s0;
                    const f32x4 e0 = *(const LAS f32x4*)es, e1 = *(const LAS f32x4*)(es + 4);
#pragma unroll
                    for (int e = 0; e < 8; ++e) mv[e] = cbf[e] * (el * (e < 4 ? e0[e] : e1[e - 4]));
                }
                bf16x8 mb; { u32x4 t; t.x = cvt_pk_bf16(mv[0], mv[1]); t.y = cvt_pk_bf16(mv[2], mv[3]); t.z = cvt_pk_bf16(mv[4], mv[5]); t.w = cvt_pk_bf16(mv[6], mv[7]); mb = *(bf16x8*)&t; }
                const bf16x8 a = *(const LAS bf16x8*)(L + CH_XS + (pj * 32 + r) * PITCH + ks * 32 + hh * 16);
                yd = MFMA32(a, mb, yd);
                cbv[j] = *(const u32x4*)(cbrow_n + j * 512);
                if (j < 4) stv[j] = *(const u32x2*)(yr_n + (size_t)j * 32 * DSSD);
            }
        }
        u32x4 ow[2];
        {
            u32x2 o[4];
#pragma unroll
            for (int q = 0; q < 4; ++q) o[q] = (u32x2){cvt_pk_bf16(yd[4 * q], yd[4 * q + 1]), cvt_pk_bf16(yd[4 * q + 2], yd[4 * q + 3])};
            if (!pass) {
                bf16_t* ys = Y + (size_t)row0 * DSSD + sto;
#pragma unroll
                for (int q = 0; q < 4; ++q) *(u32x2*)(ys + (size_t)q * 32 * DSSD) = o[q];
            } else {
#pragma unroll
                for (int kk = 0; kk < 2; ++kk) {
                    u32x2 a = o[2 * kk], bq = o[2 * kk + 1];
                    { auto t = __builtin_amdgcn_permlane32_swap(a.x, bq.x, false, false); a.x = t[0]; bq.x = t[1]; }
                    { auto t = __builtin_amdgcn_permlane32_swap(a.y, bq.y, false, false); a.y = t[0]; bq.y = t[1]; }
                    ow[kk] = (u32x4){a.x, a.y, bq.x, bq.y};
                }
            }
        }
        if (step == NCB - 1) {
            if (pass) { CH_LDS_BARRIER(); bf16_t* yrow = Y + (size_t)row0 * DSSD + yoff; *(u32x4*)yrow = ow[0]; *(u32x4*)(yrow + 16) = ow[1]; }
            break;
        }
        if (F.wave == 0) chain_scalars(scn, ean, lane_, nd0, nd1, pass ? Af : Ab, pass != 0, true);
        else if (F.wave == 1 && pass) chain_scalars(scn, ean, lane_, nd0, nd1, Ab, false, false);
        CH_LDS_BARRIER();
        if (pass) { bf16_t* yrow = Y + (size_t)row0 * DSSD + yoff; *(u32x4*)yrow = ow[0]; *(u32x4*)(yrow + 16) = ow[1]; }
        chain_write_tiles<pass>(L, tid_, scn, xv, bv, cv);
    }
#undef CH_ISSUE_CB
#undef CH_LANE_VARS
#undef CH_CIDX
    asm volatile("s_waitcnt vmcnt(0)" ::: "memory");
    __syncthreads();
    __builtin_amdgcn_fence(__ATOMIC_ACQUIRE, "agent");
}
__device__ __forceinline__ void chain_unit(const Params& p, const Ctx& F, int layer, int unit) { chain_pass<0>(p, F, layer, unit); chain_pass<1>(p, F, layer, unit); }
__device__ __forceinline__ void phase_chain(const Params& p, const Ctx& F, int layer) {
    for (int u = F.bid; u < NB * NH; u += F.G) {
        int unit = u;
        if (F.G == 256) { const int x = u & 7, j = u >> 3, pi = x * 4 + (j >> 3); unit = (pi >> 2) * 32 + (pi & 3) * 8 + (j & 7); }
        chain_unit(p, F, layer, unit);
    }
}
constexpr size_t CNTB_TILEE = 16384, CNTB_NT = 20480;
__device__ __forceinline__ void phase_moe_route(const Params& p, const Ctx& F) {
    const int layer = 1;
    bf16_t* H2 = (bf16_t*)(p.ws + D_H2M); int* TOKE = (int*)(p.ws + WS_TOKE); float* TOKP = (float*)(p.ws + WS_TOKP); int* CNTB = (int*)(p.ws + WS_CNTB);
    LAS int* cnt = (LAS int*)F.lds;
    const float* g = p.norm2_g + layer * DM;
    for (int blk = F.bid; blk < NB * SEQ / 128; blk += F.G) {
        __syncthreads();
        if (F.tid < 8) cnt[F.tid] = 0;
        { const int b0 = (blk * 128) / SEQ; const float* sh0 = (const float*)(p.ws + WS_MOD) + ((size_t)(layer * 9 + b0) * 6 + 3) * DM; const float* sc0 = sh0 + DM;
          LAS float* mA = (LAS float*)(F.lds + 1024); LAS float* mB = mA + DM;
#pragma unroll
          for (int k = 0; k < 2; ++k) { const int i = F.tid + 512 * k; mA[i] = g[i] * (sc0[i] + 1.0f); mB[i] = sh0[i]; } }
        __syncthreads();
        f32x4 wr[4][4][2];
#pragma unroll
        for (int q = 0; q < 4; ++q)
#pragma unroll
            for (int j = 0; j < 4; ++j) { const float* wp = p.moe_router_w + (size_t)(q * 256 + F.lane * 4 + j) * NE; wr[q][j][0] = *(const f32x4*)wp; wr[q][j][1] = *(const f32x4*)(wp + 4); }
        const f32x4 rb0 = *(const f32x4*)p.moe_router_b, rb1 = *(const f32x4*)(p.moe_router_b + 4);
        f32x4 vn[4];
        { const float* xr0 = p.out + (size_t)(blk * 128 + F.wave * 16) * DM;
#pragma unroll
          for (int q = 0; q < 4; ++q) vn[q] = *(const f32x4*)(xr0 + q * 256 + F.lane * 4); }
#pragma unroll 1
        for (int i = 0; i < 16; ++i) {
            const int t = blk * 128 + F.wave * 16 + i, b = t / SEQ;
            (void)b;
            f32x4 v[4]; float ss = 0.f;
#pragma unroll
            for (int q = 0; q < 4; ++q) { v[q] = vn[q]; ss += v[q][0] * v[q][0] + v[q][1] * v[q][1] + v[q][2] * v[q][2] + v[q][3] * v[q][3]; }
            { const float* xrn = p.out + (size_t)(t + (i < 15 ? 1 : 0)) * DM;
#pragma unroll
              for (int q = 0; q < 4; ++q) vn[q] = *(const f32x4*)(xrn + q * 256 + F.lane * 4); }
            ss = wave_sum(ss, F.lane);
            const float rs = rsqrtf(ss * (1.0f / DM) + EPS);
            f32x4 l0 = (f32x4){0.f, 0.f, 0.f, 0.f}, l1 = l0; float am = 0.f;
#pragma unroll
            for (int q = 0; q < 4; ++q) {
                const int col = q * 256 + F.lane * 4;
                const f32x4 ma = *(const LAS f32x4*)((LAS float*)(F.lds + 1024) + col), mb = *(const LAS f32x4*)((LAS float*)(F.lds + 1024) + DM + col);
                const f32x4 o = v[q] * rs * ma + mb; v[q] = o;
                am = __builtin_fmaxf(am, __builtin_fmaxf(__builtin_fmaxf(__builtin_fabsf(o[0]), __builtin_fabsf(o[1])), __builtin_fmaxf(__builtin_fabsf(o[2]), __builtin_fabsf(o[3]))));
#pragma unroll
                for (int j = 0; j < 4; ++j) { l0 += wr[q][j][0] * o[j]; l1 += wr[q][j][1] * o[j]; }
            }
            float inv = 0.f;
            if (UP_MODE == 2) { am = wave_max(am, F.lane); const float scl = am > 0.f ? am * (1.0f / 127.f) : 1.0f; inv = 1.0f / scl; if (F.lane == 0) ((float*)(p.ws + WS_SA))[t] = scl; }
#pragma unroll
            for (int q = 0; q < 4; ++q) {
                const int col = q * 256 + F.lane * 4; const f32x4 o = v[q];
                if (UP_MODE == 2) *(unsigned*)((unsigned char*)H2 + (size_t)t * DM + col) = pack_i8x4(o[0], o[1], o[2], o[3], inv);
                else if (UP_MODE == 1) *(unsigned*)((unsigned char*)H2 + (size_t)t * DM + col) = cvt_pk4_fp8(o[0], o[1], o[2], o[3]);
                else *(u32x2*)(H2 + (size_t)t * DM + col) = (u32x2){cvt_pk_bf16(o[0], o[1]), cvt_pk_bf16(o[2], o[3])};
            }
            float lg[8];
#pragma unroll
            for (int e = 0; e < 4; ++e) { lg[e] = wave_sum(l0[e], F.lane) + rb0[e]; lg[4 + e] = wave_sum(l1[e], F.lane) + rb1[e]; }
            int i0 = 0; float v0 = lg[0];
#pragma unroll
            for (int e = 1; e < 8; ++e) if (lg[e] > v0) { v0 = lg[e]; i0 = e; }
            int i1 = -1; float v1 = -3.0e38f;
#pragma unroll
            for (int e = 0; e < 8; ++e) if (e != i0 && lg[e] > v1) { v1 = lg[e]; i1 = e; }
            const float p0 = 1.0f / (1.0f + __expf(v1 - v0));
            if (F.lane == 0) { TOKE[t * 2] = i0; TOKE[t * 2 + 1] = i1; TOKP[t * 2] = p0; TOKP[t * 2 + 1] = 1.0f - p0; atomicAdd((int*)&cnt[i0], 1); atomicAdd((int*)&cnt[i1], 1); }
        }
        __syncthreads();
        if (F.tid < 8) CNTB[blk * 8 + F.tid] = cnt[F.tid];
    }
}
__device__ __forceinline__ void phase_moe_sort(const Params& p, const Ctx& F) {
    const bf16_t* H2 = (const bf16_t*)(p.ws + D_H2M); bf16_t* H2S = (bf16_t*)(p.ws + D_H2S);
    const int* TOKE = (const int*)(p.ws + WS_TOKE); int* TOKS = (int*)(p.ws + WS_TOKS); const int* CNTB = (const int*)(p.ws + WS_CNTB);
    int* TILEE = (int*)(p.ws + WS_CNTB + CNTB_TILEE); int* NT = (int*)(p.ws + WS_CNTB + CNTB_NT);
    LAS int* tot = (LAS int*)F.lds; LAS int* pre = tot + 8; LAS int* off = tot + 16; LAS int* wt = tot + 32; LAS int* slots = tot + 64;
    for (int blk = F.bid; blk < NB * SEQ / 128; blk += F.G) {
        __syncthreads();
        if (F.tid < 64) tot[F.tid] = 0;
        __syncthreads();
        if (F.tid < 256) {
#pragma unroll
            for (int e = 0; e < 8; ++e) { const int cv = CNTB[F.tid * 8 + e]; atomicAdd((int*)&tot[e], cv); if (F.tid < blk) atomicAdd((int*)&pre[e], cv); }
        }
        __syncthreads();
        if (F.tid == 0) { int o = 0; for (int e = 0; e < 8; ++e) { off[e] = o; o += (tot[e] + 255) & ~255; } off[8] = o; }
        __syncthreads();
        if (blk == 0 && F.tid < MOE_MAXT) { const int r0 = F.tid * 256; int e = 7; for (int k = 7; k >= 0; --k) if (r0 < off[k + 1]) e = k; TILEE[F.tid] = e; if (F.tid == 0) NT[0] = off[8] >> 8; }
        int e0 = 0, e1 = 0, rk0 = 0, rk1 = 0;
        if (F.tid < 128) {
            const int t = blk * 128 + F.tid; e0 = TOKE[t * 2]; e1 = TOKE[t * 2 + 1];
            const unsigned long long lt = (F.lane == 0) ? 0ull : (~0ull >> (64 - F.lane));
#pragma unroll
            for (int e = 0; e < 8; ++e) {
                const unsigned long long m = __ballot(e0 == e || e1 == e);
                const int rk = __popcll(m & lt);
                if (e0 == e) rk0 = rk; if (e1 == e) rk1 = rk;
                if (F.lane == 0) wt[F.wave * 8 + e] = __popcll(m);
            }
        }
        __syncthreads();
        if (F.tid < 128) {
            const int t = blk * 128 + F.tid;
            const int s0 = off[e0] + pre[e0] + rk0 + (F.wave ? wt[e0] : 0), s1 = off[e1] + pre[e1] + rk1 + (F.wave ? wt[e1] : 0);
            TOKS[t * 2] = s0; TOKS[t * 2 + 1] = s1; slots[F.tid * 2] = s0; slots[F.tid * 2 + 1] = s1;
            if (UP_MODE == 2) { const float sa = ((const float*)(p.ws + WS_SA))[t]; ((float*)(p.ws + WS_SA2))[s0] = sa; ((float*)(p.ws + WS_SA2))[s1] = sa; }
        }
        __syncthreads();
        constexpr int RC = DM * UPESZ / 16;
        static_assert((256 * RC) % (512 * 8) == 0, "copy batches");
#pragma unroll 1
        for (int base = F.tid; base < 256 * RC; base += 512 * 8) {
            u32x4 tmp[8];
#pragma unroll
            for (int k = 0; k < 8; ++k) { const int id = base + 512 * k, pr = id / RC, q = id % RC; tmp[k] = *(const u32x4*)((const unsigned char*)H2 + ((size_t)(blk * 128 + (pr >> 1)) * DM * UPESZ + q * 16)); }
#pragma unroll
            for (int k = 0; k < 8; ++k) { const int id = base + 512 * k, pr = id / RC, q = id % RC; *(u32x4*)((unsigned char*)H2S + ((size_t)slots[pr] * DM * UPESZ + q * 16)) = tmp[k]; }
        }
    }
}
__device__ __forceinline__ void phase_final(const Params& p, const Ctx& F) {
    const bf16_t* O = (const bf16_t*)(p.ws + D_O); const int* TOKS = (const int*)(p.ws + WS_TOKS); const float* TOKP = (const float*)(p.ws + WS_TOKP);
    f32x4 gf[4];
#pragma unroll
    for (int q = 0; q < 4; ++q) gf[q] = *(const f32x4*)(p.final_norm_g + q * 256 + F.lane * 4);
    for (int pr = F.bid * 8 + F.wave; 2 * pr < NB * SEQ; pr += F.G * 8) {
        const int t0 = 2 * pr, b = t0 / SEQ; float* xr = p.out + (size_t)t0 * DM;
        const float* gate = (const float*)(p.ws + WS_MOD) + ((size_t)(1 * 9 + b) * 6 + 5) * DM;
        const u32x4 sl = *(const u32x4*)(TOKS + t0 * 2); const f32x4 pp = *(const f32x4*)(TOKP + t0 * 2);
        f32x4 v[2][4]; float ss[2] = {0.f, 0.f};
#pragma unroll
        for (int e = 0; e < 2; ++e) { const int s0 = e ? (int)sl.z : (int)sl.x, s1 = e ? (int)sl.w : (int)sl.y; const float p0 = e ? pp[2] : pp[0], p1 = e ? pp[3] : pp[1];
#pragma unroll
            for (int q = 0; q < 4; ++q) {
                const int col = q * 256 + F.lane * 4;
                const u32x2 a = *(const u32x2*)(O + (size_t)s0 * DM + col), c = *(const u32x2*)(O + (size_t)s1 * DM + col);
                const f32x4 gg = *(const f32x4*)(gate + col); f32x4 x = *(const f32x4*)(xr + e * DM + col);
                x[0] += gg[0] * (p0 * bf_lo(a.x) + p1 * bf_lo(c.x)); x[1] += gg[1] * (p0 * bf_hi(a.x) + p1 * bf_hi(c.x));
                x[2] += gg[2] * (p0 * bf_lo(a.y) + p1 * bf_lo(c.y)); x[3] += gg[3] * (p0 * bf_hi(a.y) + p1 * bf_hi(c.y));
                v[e][q] = x; ss[e] += x[0] * x[0] + x[1] * x[1] + x[2] * x[2] + x[3] * x[3];
            } }
        { ss[0] = wave_sum(ss[0], F.lane); ss[1] = wave_sum(ss[1], F.lane); }
#pragma unroll
        for (int e = 0; e < 2; ++e) { const float rs = rsqrtf(ss[e] * (1.0f / DM) + EPS);
#pragma unroll
            for (int q = 0; q < 4; ++q) *(f32x4*)(xr + e * DM + q * 256 + F.lane * 4) = v[e][q] * rs * gf[q]; }
    }
}
constexpr int NPH = 27;
#ifndef DBG_NPH
#define DBG_NPH NPH
#endif
__device__ __forceinline__ pg8::Sched make_sched(const Ctx& F, int nM, int nN, bool lat_only) {
    pg8::Sched S{}; S.nM = nM; S.nN = nN; S.G = F.G; S.c = F.bid; S.nseg = 1; S.lat_only = lat_only ? 1 : 0; S.tm0 = 0; S.tileE = nullptr; S.bstrideE = 0;
    S.A0 = S.A1 = S.B0 = S.B1 = nullptr; S.lda0 = S.lda1 = S.K0 = S.K1 = 0; return S;
}
typedef const __attribute__((address_space(4))) Params* KP4;
__device__ __forceinline__ const Params& fresh_params() { KP4 q = (KP4)__builtin_amdgcn_kernarg_segment_ptr(); asm volatile("" : "+s"(q)); return *(const Params*)q; }
__device__ __forceinline__ Ctx fresh_ctx(LAS unsigned char* lds, int wave_s) { Ctx F; unsigned m_ = ~0u; asm volatile("" : "+s"(m_)); int t = wave_s * 64 + (int)__builtin_amdgcn_mbcnt_hi(m_, __builtin_amdgcn_mbcnt_lo(m_, 0u)); asm volatile("" : "+v"(t)); unsigned l32 = (unsigned)(unsigned long long)lds; int g = gridDim.x, b = blockIdx.x; asm volatile("" : "+s"(l32), "+s"(g), "+s"(b));
    F.lds = (LAS unsigned char*)(unsigned long long)l32; F.tid = t; F.lane = t & 63; F.wave = __builtin_amdgcn_readfirstlane(t >> 6); F.G = g; F.bid = b; return F; }
__global__ void __launch_bounds__(512, 2) hybrid_fwd(Params p_arg) {
    extern __shared__ __attribute__((aligned(16))) unsigned char lds_raw[];
    LAS unsigned char* const lds0 = (LAS unsigned char*)lds_raw;
    volatile LAS unsigned* misc = (volatile LAS unsigned*)(lds0 + LDS_MISC);
    const int wave_s = __builtin_amdgcn_readfirstlane(threadIdx.x >> 6);
    if (threadIdx.x < 64) misc[threadIdx.x] = 0u;
    __syncthreads();
    XcdBarrier bar; bar.bar = (unsigned*)(p_arg.ws + WS_CTL); bar.x = 0; bar.st = nullptr;
#if !MK_PER_PHASE
    bar = xcd_barrier_post((unsigned*)(p_arg.ws + WS_CTL), misc + 8);
#endif
    const int lo = p_arg.ph_lo, hi = p_arg.ph_hi;
#define IN(k) (lo <= (k) && (k) < hi)
#define DEFER(F) ((F).G == 256 && lo == 0 && hi == NPH)
#if MK_PER_PHASE
#define SEAM(k) do { } while (0)
#else
#define SEAM(k) do { if (IN((k) + 1)) xcd_barrier(bar); } while (0)
#endif
    if (IN(0)) { const Params& p = fresh_params(); const Ctx F = fresh_ctx(lds0, wave_s); phase_prologue(p, F, !DEFER(F)); SEAM(0); }
#pragma unroll 1
    for (int l = 0; l < 2; ++l) {
        const int l_ = l;
        const int base = l ? 12 : 1;
        if (IN(base + 0)) { const Params& p = fresh_params(); const Ctx F = fresh_ctx(lds0, wave_s); unsigned char* const ws = p.ws; unsigned char* const wl = ws + WS_WL + (size_t)l_ * WL_STRIDE; (void)wl; phase_norm(p, F, l, l, p.norm1_g + l * DM, 0, (bf16_t*)(ws + D_H), false, IN_MODE, (float*)(ws + WS_SA)); SEAM(base + 0); }
        if (IN(base + 1)) { const Params& p = fresh_params(); const Ctx F = fresh_ctx(lds0, wave_s); unsigned char* const ws = p.ws; unsigned char* const wl = ws + WS_WL + (size_t)l_ * WL_STRIDE; (void)wl;
            pg8::Sched S = make_sched(F, NTILE, NG1 / 256, false); S.A0 = (const char*)(ws + D_H); S.lda0 = DM * INESZ; S.K0 = DM * INESZ; S.B0 = (const char*)(wl + WL_G1);
            EpiG1 E{(bf16_t*)(ws + D_XBC), (float*)(ws + WS_DT), p.dt_bias + l * 64, (const float*)(ws + WS_SA), (const float*)(ws + WS_SW) + l * SW_L};
            pg8::gemm_phase<EpiG1, false, IN_MODE>(F.lds, F.tid, S, E); SEAM(base + 1); }
        if (IN(base + 2)) { const Params& p = fresh_params(); const Ctx F = fresh_ctx(lds0, wave_s); unsigned char* const ws = p.ws; unsigned char* const wl = ws + WS_WL + (size_t)l_ * WL_STRIDE; (void)wl; phase_conv(p, F, l); SEAM(base + 2); }
        if (IN(base + 3)) { const Params& p = fresh_params(); const Ctx F = fresh_ctx(lds0, wave_s); unsigned char* const ws = p.ws; unsigned char* const wl = ws + WS_WL + (size_t)l_ * WL_STRIDE; (void)wl; phase_chain(p, F, l); SEAM(base + 3); }
        if (IN(base + 4)) { const Params& p = fresh_params(); const Ctx F = fresh_ctx(lds0, wave_s); unsigned char* const ws = p.ws; unsigned char* const wl = ws + WS_WL + (size_t)l_ * WL_STRIDE; (void)wl;
            pg8::Sched S = make_sched(F, l ? NLT : NTILE, NG2 / 256, l != 0); S.A0 = (const char*)(ws + D_H); S.lda0 = DM * INESZ; S.K0 = DM * INESZ; S.B0 = (const char*)(wl + WL_G2);
            EpiG2 E{(bf16_t*)(ws + D_Y), (bf16_t*)(ws + D_G), (bf16_t*)(ws + D_U), (bf16_t*)(ws + D_V), (float*)(ws + WS_SSQ1), (float*)(ws + WS_SSQ2), (const float*)(ws + WS_SA), (const float*)(ws + WS_SW) + l * SW_L + NG1};
            pg8::gemm_phase<EpiG2, false, IN_MODE>(F.lds, F.tid, S, E); SEAM(base + 4); }
        if (IN(base + 5)) { const Params& p = fresh_params(); const Ctx F = fresh_ctx(lds0, wave_s); unsigned char* const ws = p.ws; unsigned char* const wl = ws + WS_WL + (size_t)l_ * WL_STRIDE; (void)wl; phase_gmlp(p, F, l, l != 0); SEAM(base + 5); }
        if (IN(base + 6)) { const Params& p = fresh_params(); const Ctx F = fresh_ctx(lds0, wave_s); unsigned char* const ws = p.ws; unsigned char* const wl = ws + WS_WL + (size_t)l_ * WL_STRIDE; (void)wl;
            pg8::Sched S = make_sched(F, l ? NLT : NTILE, DM / 256, l != 0); S.nseg = 2;
            S.A0 = (const char*)(ws + D_Y); S.lda0 = DSSD * 2; S.K0 = DSSD * 2; S.B0 = (const char*)(wl + WL_W1);
            S.A1 = (const char*)(ws + D_U); S.lda1 = DM * 2; S.K1 = DM * 2; S.B1 = (const char*)(wl + WL_W2);
            EpiMerge E{(const bf16_t*)(ws + D_G), (const float*)(ws + WS_SSQ1), (bf16_t*)(ws + D_MG)};
            pg8::gemm_phase<EpiMerge, true>(F.lds, F.tid, S, E);
            if (l == 0 && DEFER(F) && F.bid >= 32) moe_weight_convert(p, F, 0, NE, F.bid - 32, F.G - 32);
            SEAM(base + 6); }
        if (IN(base + 7)) { const Params& p = fresh_params(); const Ctx F = fresh_ctx(lds0, wave_s); unsigned char* const ws = p.ws; unsigned char* const wl = ws + WS_WL + (size_t)l_ * WL_STRIDE; (void)wl;
            pg8::Sched S = make_sched(F, l ? NLT : NTILE, DM / 256, l != 0); S.A0 = (const char*)(ws + D_MG); S.lda0 = DM * 2; S.K0 = DM * 2; S.B0 = (const char*)(wl + WL_WO);
            EpiRes E{l ? (const float*)p.out : p.x, l ? (const float*)(ws + WS_CTXRES) : p.ctx, p.out, (float*)(ws + WS_CTXRES), (const float*)(ws + WS_MOD), l, 2};
            pg8::gemm_phase<EpiRes>(F.lds, F.tid, S, E);
            if (l == 0 && DEFER(F) && F.bid >= 32) convert_jobs(p, F, 9, 18, F.bid - 32, F.G - 32);
            SEAM(base + 7); }
        if (l == 0) {
    if (IN(9)) { const Params& p = fresh_params(); const Ctx F = fresh_ctx(lds0, wave_s); unsigned char* const ws = p.ws; unsigned char* const wl = ws + WS_WL + (size_t)l_ * WL_STRIDE; (void)wl; phase_norm(p, F, 0, 1, p.norm2_g, 3, (bf16_t*)(ws + D_H2), false, UP_MODE, (float*)(ws + WS_SA)); SEAM(9); }
    if (IN(10)) { const Params& p = fresh_params(); const Ctx F = fresh_ctx(lds0, wave_s); unsigned char* const ws = p.ws; unsigned char* const wl = ws + WS_WL + (size_t)l_ * WL_STRIDE; (void)wl;
        pg8::Sched S = make_sched(F, NTILE, 2 * DFF / 256, false); S.A0 = (const char*)(ws + D_H2); S.lda0 = DM * UPESZ; S.K0 = DM * UPESZ; S.B0 = (const char*)(ws + WS_FGU);
        EpiGlu E{(bf16_t*)(ws + D_HD), DFF, 0, (const float*)(ws + WS_SA), (const float*)(ws + WS_SW) + SW_FGU, nullptr, nullptr};
        pg8::gemm_phase<EpiGlu, false, UP_MODE>(F.lds, F.tid, S, E); SEAM(10); }
    if (IN(11)) { const Params& p = fresh_params(); const Ctx F = fresh_ctx(lds0, wave_s); unsigned char* const ws = p.ws; unsigned char* const wl = ws + WS_WL + (size_t)l_ * WL_STRIDE; (void)wl;
        pg8::Sched S = make_sched(F, NTILE, DM / 256, false); S.A0 = (const char*)(ws + D_HD); S.lda0 = DFF * FESZ; S.K0 = DFF * FESZ; S.B0 = (const char*)(ws + WS_FD);
        typedef EpiResT<E8_W, E8_HD> EpiResF; EpiResF E{(const float*)p.out, (const float*)(ws + WS_CTXRES), p.out, (float*)(ws + WS_CTXRES), (const float*)(ws + WS_MOD), 0, 5};
        pg8::gemm_phase<EpiResF, false, DN_MODE>(F.lds, F.tid, S, E);
        SEAM(11); }
        } else {
    if (IN(20)) { const Params& p = fresh_params(); const Ctx F = fresh_ctx(lds0, wave_s); unsigned char* const ws = p.ws; unsigned char* const wl = ws + WS_WL + (size_t)l_ * WL_STRIDE; (void)wl; phase_moe_route(p, F); if (!DEFER(F)) moe_weight_convert(p, F, 0, NE, F.bid, F.G); SEAM(20); }
    if (IN(21)) { const Params& p = fresh_params(); const Ctx F = fresh_ctx(lds0, wave_s); unsigned char* const ws = p.ws; unsigned char* const wl = ws + WS_WL + (size_t)l_ * WL_STRIDE; (void)wl; phase_moe_sort(p, F); SEAM(21); }
#pragma unroll 1
    for (int half = 0; half < 2; ++half) {
        const int ntiles = *(const int*)(fresh_params().ws + WS_CNTB + CNTB_NT);
        const int tm0 = half * MOE_SPLIT; int nM = half ? ntiles - MOE_SPLIT : MOE_SPLIT; nM = nM < 0 ? 0 : (nM > MOE_HALF ? MOE_HALF : nM); if (!half && nM > ntiles) nM = ntiles;
        if (IN(22 + 2 * half)) { const Params& p = fresh_params(); const Ctx F = fresh_ctx(lds0, wave_s); unsigned char* const ws = p.ws; unsigned char* const wl = ws + WS_WL + (size_t)l_ * WL_STRIDE; (void)wl;
            { LAS int* tl = (LAS int*)(F.lds + 131072); if (F.tid < MOE_MAXT) tl[F.tid] = ((const int*)(ws + WS_CNTB + CNTB_TILEE))[F.tid]; __syncthreads(); }
            pg8::Sched S = make_sched(F, nM, 2 * DFFE / 256, false); S.tm0 = tm0; S.tileE = (const int*)(ws + WS_CNTB + CNTB_TILEE); S.bstrideE = WMOE_E; S.tileL = (const LAS int*)(F.lds + 131072);
            S.A0 = (const char*)(ws + D_H2S); S.lda0 = DM * UPESZ; S.K0 = DM * UPESZ; S.B0 = (const char*)(ws + D_WMOE);
            EpiGlu E{(bf16_t*)(ws + D_HDM), DFFE, tm0, (const float*)(ws + WS_SA2), (const float*)(ws + WS_SW) + SW_MOE, (const int*)(ws + WS_CNTB + CNTB_TILEE), (const char*)(ws + D_WMOE)};
            pg8::gemm_phase<EpiGlu, false, UP_MODE>(F.lds, F.tid, S, E); SEAM(22 + 2 * half); }
        if (IN(23 + 2 * half)) { const Params& p = fresh_params(); const Ctx F = fresh_ctx(lds0, wave_s); unsigned char* const ws = p.ws; unsigned char* const wl = ws + WS_WL + (size_t)l_ * WL_STRIDE; (void)wl;
            { LAS int* tl = (LAS int*)(F.lds + 131072); if (F.tid < MOE_MAXT) tl[F.tid] = ((const int*)(ws + WS_CNTB + CNTB_TILEE))[F.tid]; __syncthreads(); }
            pg8::Sched S = make_sched(F, nM, DM / 256, false); S.tm0 = tm0; S.tileE = (const int*)(ws + WS_CNTB + CNTB_TILEE); S.bstrideE = WMOE_E; S.tileL = (const LAS int*)(F.lds + 131072);
            S.A0 = (const char*)(ws + D_HDM) - (size_t)tm0 * 256 * DFFE * FESZ; S.lda0 = DFFE * FESZ; S.K0 = DFFE * FESZ; S.B0 = (const char*)(ws + D_WMOE) + WMOE_UP;
            EpiBf E{(bf16_t*)(ws + D_O), DM};
            pg8::gemm_phase<EpiBf, false, DN_MODE>(F.lds, F.tid, S, E); SEAM(23 + 2 * half); }
    }
    if (IN(26)) { const Params& p = fresh_params(); const Ctx F = fresh_ctx(lds0, wave_s); unsigned char* const ws = p.ws; unsigned char* const wl = ws + WS_WL + (size_t)l_ * WL_STRIDE; (void)wl; phase_final(p, F); }
        }
    }
#undef IN
#undef DEFER
#undef SEAM
}

#ifdef DBG_DUMP_OFF
__global__ void dbg_dump(const unsigned char* ws, float* out) {
    const size_t N = (size_t)NB * SEQ * DM; const size_t E = (size_t)DBG_DUMP_BYTES / (DBG_DUMP_KIND ? 4 : 2);
    for (size_t i = (size_t)blockIdx.x * blockDim.x + threadIdx.x; i < N; i += (size_t)gridDim.x * blockDim.x) {
        float s = 0.f;
        for (size_t k = i; k < E; k += N) s += DBG_DUMP_KIND ? ((const float*)(ws + DBG_DUMP_OFF))[k] : bf2f(((const bf16_t*)(ws + DBG_DUMP_OFF))[k]);
        out[i] = s;
    }
}
#endif
extern "C" void kernel_launch(void* const* d_in, const int* in_sizes, int n_in, void* d_out, int out_size, void* d_ws, size_t ws_size, hipStream_t stream) {
    static int grid = 0;
    if (grid == 0) {
        if (n_in != 30 || in_sizes[0] != NB * SEQ * DM || out_size != NB * SEQ * DM || ws_size < WS_NEED) {
            fprintf(stderr, "kernel_launch: unexpected problem (n_in %d, in0 %d, out %d, ws %zu, need %zu); nothing launched\n", n_in, n_in > 0 ? in_sizes[0] : -1, out_size, ws_size, (size_t)WS_NEED); grid = -1; return; }
        int dev = 0, cus = 0, per_cu = 0;
        if (hipGetDevice(&dev) != hipSuccess || hipDeviceGetAttribute(&cus, hipDeviceAttributeMultiprocessorCount, dev) != hipSuccess) { grid = -1; return; }
        if (hipFuncSetAttribute((const void*)hybrid_fwd, hipFuncAttributeMaxDynamicSharedMemorySize, LDS_BYTES) != hipSuccess) { fprintf(stderr, "kernel_launch: hipFuncSetAttribute failed\n"); grid = -1; return; }
        if (hipOccupancyMaxActiveBlocksPerMultiprocessor(&per_cu, (const void*)hybrid_fwd, 512, LDS_BYTES) != hipSuccess || per_cu < 1)
            fprintf(stderr, "kernel_launch: note: occupancy query reports %d workgroups per CU\n", per_cu);
        (void)hipGetLastError();
        grid = cus;
    }
    if (grid < 0) return;
    if (hipMemsetAsync((char*)d_ws + WS_CTL, 0, CTL_BYTES, stream) != hipSuccess) return;
    Params P; memset(&P, 0, sizeof(P));
    const float** f = (const float**)&P;
    for (int i = 0; i < 30; ++i) f[i] = (const float*)d_in[i];
    P.out = (float*)d_out; P.ws = (unsigned char*)d_ws;
#if MK_PER_PHASE
    for (int ph = 0; ph < DBG_NPH; ++ph) { P.ph_lo = ph; P.ph_hi = ph + 1; hipLaunchKernelGGL(hybrid_fwd, dim3(grid), dim3(512), LDS_BYTES, stream, P); }
#ifdef DBG_DUMP_OFF
    hipLaunchKernelGGL(dbg_dump, dim3(2048), dim3(256), 0, stream, (const unsigned char*)d_ws, (float*)d_out);
#endif
#else
    P.ph_lo = 0; P.ph_hi = NPH;
    hipLaunchKernelGGL(hybrid_fwd, dim3(grid), dim3(512), LDS_BYTES, stream, P);
#endif
}
```
